# Optimizing an MI355X kernel written in HIP

```python
import math
import jax, jax.numpy as jnp
from jax import lax
import numpy as np

D_MODEL = 2048
BATCH = 4
SEQ = 4096
DEPTH = 1

MIX_WIDTH = D_MODEL
ATTN_WIDTH = MIX_WIDTH // 2
SSM_WIDTH = MIX_WIDTH - ATTN_WIDTH
N_HEADS = 8
DK = ATTN_WIDTH // N_HEADS // 2
DV = 2 * DK
Q_BLOCK = 128
N_BUCKETS = 32
MAX_DISTANCE = 128
SSM_GROUP = 16
SSM_GROUPS = SSM_WIDTH // SSM_GROUP
SSM_STATE = 64
N_EXPERT_GROUPS = 4
EXPERTS_PER_GROUP = 8
N_EXPERTS = N_EXPERT_GROUPS * EXPERTS_PER_GROUP
TOP_K = 2
D_EXPERT = D_MODEL // 4
EXPERT_BLOCK = 128
PLE_DIM = 256
PROJ_WIDTH = 3 * ATTN_WIDTH + SSM_WIDTH

kernel_name = "hymba_diffattn_s5_hiermoe_ple"


def rms_norm(x, g, eps=1e-6):
    x32 = x.astype(jnp.float32)
    y = x32 * lax.rsqrt(jnp.mean(x32 * x32, axis=-1, keepdims=True) + eps)
    return (y * g.astype(jnp.float32)).astype(x.dtype)


def t5_causal_bucket(n):
    n = jnp.maximum(n, 0)
    max_exact = N_BUCKETS // 2
    is_small = n < max_exact
    nf = jnp.maximum(n, 1).astype(jnp.float32)
    large = max_exact + (jnp.log(nf / max_exact) / math.log(MAX_DISTANCE / max_exact)
                         * (N_BUCKETS - max_exact)).astype(jnp.int32)
    large = jnp.minimum(large, N_BUCKETS - 1)
    return jnp.where(is_small, n, large)


def diff_attention(zq, zk, zv, rel_bias, lq1, lk1, lq2, lk2, subln_g, lam_init):
    bt, s_len = zq.shape[0], zq.shape[1]
    q = zq.reshape(bt, s_len, N_HEADS, 2, DK).transpose(0, 2, 3, 1, 4)
    k = zk.reshape(bt, s_len, N_HEADS, 2, DK).transpose(0, 2, 3, 1, 4)
    v = zv.reshape(bt, s_len, N_HEADS, DV).transpose(0, 2, 1, 3)
    lam = (jnp.exp(jnp.sum(lq1.astype(jnp.float32) * lk1.astype(jnp.float32)))
           - jnp.exp(jnp.sum(lq2.astype(jnp.float32) * lk2.astype(jnp.float32)))
           + lam_init)
    scale = DK ** -0.5
    kpos = jnp.arange(s_len, dtype=jnp.int32)
    table = rel_bias.astype(jnp.float32)

    def block(bi):
        start = bi * Q_BLOCK
        qb = lax.dynamic_slice_in_dim(q, start, Q_BLOCK, axis=3)
        sc = jnp.einsum('bhcqd,bhckd->bhcqk', qb, k).astype(jnp.float32) * scale
        qpos = start + jnp.arange(Q_BLOCK, dtype=jnp.int32)
        rel = qpos[:, None] - kpos[None, :]
        bias = table[t5_causal_bucket(rel)].transpose(2, 0, 1)
        sc = sc + bias[None, :, None]
        sc = jnp.where((rel >= 0)[None, None, None], sc, -1e30)
        pr = jax.nn.softmax(sc, axis=-1)
        a = pr[:, :, 0] - lam * pr[:, :, 1]
        return jnp.einsum('bhqk,bhkd->bhqd', a.astype(v.dtype), v)

    o = lax.map(block, jnp.arange(s_len // Q_BLOCK))
    o = o.transpose(1, 0, 3, 2, 4).reshape(bt, s_len, N_HEADS, DV)
    o = rms_norm(o, subln_g, eps=1e-5) * (1.0 - lam_init)
    return o.reshape(bt, s_len, N_HEADS * DV)


def _ssm_combine(e1, e2):
    ar1, ai1, br1, bi1 = e1
    ar2, ai2, br2, bi2 = e2
    ar = ar2 * ar1 - ai2 * ai1
    ai = ar2 * ai1 + ai2 * ar1
    br = ar2 * br1 - ai2 * bi1 + br2
    bi = ar2 * bi1 + ai2 * br1 + bi2
    return (ar, ai, br, bi)


def s5_ssm(u, lam_re, lam_im, log_dt, b_re, b_im, c_re, c_im, d_skip):
    bt, s_len = u.shape[0], u.shape[1]
    uf = u.reshape(bt, s_len, SSM_GROUPS, SSM_GROUP).astype(jnp.float32)
    lre = lam_re.astype(jnp.float32)
    lim = lam_im.astype(jnp.float32)
    dt = jnp.exp(log_dt.astype(jnp.float32))[:, None]
    mag = jnp.exp(lre * dt)
    ab_re = mag * jnp.cos(lim * dt)
    ab_im = mag * jnp.sin(lim * dt)
    den = lre * lre + lim * lim
    nr, ni = ab_re - 1.0, ab_im
    cr = ((nr * lre + ni * lim) / den)[..., None]
    ci = ((ni * lre - nr * lim) / den)[..., None]
    bre = b_re.astype(jnp.float32)
    bim = b_im.astype(jnp.float32)
    bb_re = cr * bre - ci * bim
    bb_im = cr * bim + ci * bre
    cre = c_re.astype(jnp.float32)
    cim = c_im.astype(jnp.float32)
    dsk = d_skip.astype(jnp.float32)

    def one(ub):
        bur = jnp.einsum('sgh,gph->sgp', ub, bb_re)
        bui = jnp.einsum('sgh,gph->sgp', ub, bb_im)
        ar = jnp.broadcast_to(ab_re, bur.shape)
        ai = jnp.broadcast_to(ab_im, bur.shape)
        _, _, xr, xi = lax.associative_scan(_ssm_combine, (ar, ai, bur, bui), axis=0)
        return (jnp.einsum('sgp,ghp->sgh', xr, cre)
                - jnp.einsum('sgp,ghp->sgh', xi, cim) + dsk * ub)

    y = lax.map(one, uf)
    return y.reshape(bt, s_len, SSM_GROUPS * SSM_GROUP).astype(u.dtype)


def hier_moe(h, w_rg, b_rg, w_re, b_re, w1, w3, w2):
    n_tok, d = h.shape
    tok = jnp.arange(n_tok, dtype=jnp.int32)
    lg = (h @ w_rg).astype(jnp.float32) + b_rg.astype(jnp.float32)
    pg = jax.nn.softmax(lg, axis=-1)
    gsel = jnp.argmax(lg, axis=-1).astype(jnp.int32)
    gate_g = pg[tok, gsel][:, None]
    le = ((h @ w_re).astype(jnp.float32) + b_re.astype(jnp.float32)).reshape(
        n_tok, N_EXPERT_GROUPS, EXPERTS_PER_GROUP)
    pe = jax.nn.softmax(le[tok, gsel], axis=-1)
    top_p, top_i = lax.top_k(pe, TOP_K)
    w = gate_g * top_p / jnp.sum(top_p, axis=-1, keepdims=True)
    eid = gsel[:, None] * EXPERTS_PER_GROUP + top_i.astype(jnp.int32)

    n_assign = n_tok * TOP_K
    flat_e = eid.reshape(-1)
    flat_w = w.reshape(-1)
    flat_t = jnp.repeat(tok, TOP_K)
    counts = jnp.bincount(flat_e, length=N_EXPERTS)
    padded = ((counts + EXPERT_BLOCK - 1) // EXPERT_BLOCK) * EXPERT_BLOCK
    pad_end = jnp.cumsum(padded)
    pad_start = pad_end - padded
    start = jnp.cumsum(counts) - counts
    order = jnp.argsort(flat_e)
    se = flat_e[order]
    dest = pad_start[se] + (jnp.arange(n_assign, dtype=jnp.int32) - start[se])
    m_rows = ((n_assign + EXPERT_BLOCK - 1) // EXPERT_BLOCK) * EXPERT_BLOCK + N_EXPERTS * EXPERT_BLOCK
    row_tok = jnp.full((m_rows,), n_tok, jnp.int32).at[dest].set(flat_t[order])
    row_w = jnp.zeros((m_rows,), jnp.float32).at[dest].set(flat_w[order])
    n_blk = m_rows // EXPERT_BLOCK
    blk_start = jnp.arange(n_blk, dtype=jnp.int32) * EXPERT_BLOCK
    blk_e = jnp.minimum(jnp.searchsorted(pad_end, blk_start, side='right'), N_EXPERTS - 1)
    h_pad = jnp.concatenate([h, jnp.zeros((1, d), h.dtype)], axis=0)
    xb = h_pad[row_tok].reshape(n_blk, EXPERT_BLOCK, d)

    def expert_block(args):
        xe, e = args
        return (jax.nn.silu(xe @ w1[e]) * (xe @ w3[e])) @ w2[e]

    yb = lax.map(expert_block, (xb, blk_e)).reshape(m_rows, d)
    y = jax.ops.segment_sum(yb * row_w[:, None].astype(yb.dtype), row_tok,
                            num_segments=n_tok + 1)
    return y[:n_tok]


def setup_inputs(seed: int = 0) -> dict:
    key = jax.random.key(seed)
    ks = jax.random.split(key, 40)
    f32 = jnp.float32
    nrm = lambda k, shape, s: jax.random.normal(k, shape, f32) * s
    gain = lambda k, shape: 1.0 + 0.01 * jax.random.normal(k, shape, f32)
    L, D, G, P, H = DEPTH, D_MODEL, SSM_GROUPS, SSM_STATE, SSM_GROUP
    n_idx = jnp.arange(P, dtype=f32)[None, None, :]
    return {
        "x": jax.random.normal(ks[0], (BATCH, SEQ, D), f32),
        "p": jax.random.normal(ks[1], (L, BATCH, SEQ, PLE_DIM), f32),
        "rel_bias": nrm(ks[2], (N_BUCKETS, N_HEADS), 0.1),
        "g_mix": gain(ks[3], (L, D)),
        "w_in": nrm(ks[4], (L, D, PROJ_WIDTH), D ** -0.5),
        "lam_q1": nrm(ks[5], (L, DK), 0.1),
        "lam_k1": nrm(ks[6], (L, DK), 0.1),
        "lam_q2": nrm(ks[7], (L, DK), 0.1),
        "lam_k2": nrm(ks[8], (L, DK), 0.1),
        "subln_g": gain(ks[9], (L, DV)),
        "ssm_lam_re": -0.5 + 0.01 * jax.random.normal(ks[10], (L, G, P), f32),
        "ssm_lam_im": math.pi * n_idx + 0.01 * jax.random.normal(ks[11], (L, G, P), f32),
        "ssm_log_dt": jax.random.uniform(ks[12], (L, G), f32, math.log(1e-3), math.log(1e-1)),
        "ssm_b_re": nrm(ks[13], (L, G, P, H), (2.0 * H) ** -0.5),
        "ssm_b_im": nrm(ks[14], (L, G, P, H), (2.0 * H) ** -0.5),
        "ssm_c_re": nrm(ks[15], (L, G, H, P), P ** -0.5),
        "ssm_c_im": nrm(ks[16], (L, G, H, P), P ** -0.5),
        "ssm_d": nrm(ks[17], (L, G, H), 1.0),
        "w_glu": nrm(ks[18], (L, SSM_WIDTH, SSM_WIDTH), SSM_WIDTH ** -0.5),
        "b_glu": nrm(ks[19], (L, SSM_WIDTH), 0.01),
        "ssm_norm_g": gain(ks[20], (L, SSM_WIDTH)),
        "w_o": nrm(ks[21], (L, MIX_WIDTH, D), MIX_WIDTH ** -0.5),
        "g_ffn": gain(ks[22], (L, D)),
        "w_router_g": nrm(ks[23], (L, D, N_EXPERT_GROUPS), D ** -0.5),
        "b_router_g": nrm(ks[24], (L, N_EXPERT_GROUPS), 0.01),
        "w_router_e": nrm(ks[25], (L, D, N_EXPERTS), D ** -0.5),
        "b_router_e": nrm(ks[26], (L, N_EXPERTS), 0.01),
        "w1": nrm(ks[27], (L, N_EXPERTS, D, D_EXPERT), D ** -0.5),
        "w3": nrm(ks[28], (L, N_EXPERTS, D, D_EXPERT), D ** -0.5),
        "w2": nrm(ks[29], (L, N_EXPERTS, D_EXPERT, D), D_EXPERT ** -0.5),
        "g_ple": gain(ks[30], (L, D)),
        "w_ple_gate": nrm(ks[31], (L, D, D), D ** -0.5),
        "w_ple_proj": nrm(ks[32], (L, PLE_DIM, D), PLE_DIM ** -0.5),
        "g_final": gain(ks[33], (D,)),
    }


def reference(x, p, rel_bias, g_mix, w_in, lam_q1, lam_k1, lam_q2, lam_k2, subln_g,
              ssm_lam_re, ssm_lam_im, ssm_log_dt, ssm_b_re, ssm_b_im, ssm_c_re, ssm_c_im,
              ssm_d, w_glu, b_glu, ssm_norm_g, w_o, g_ffn, w_router_g, b_router_g,
              w_router_e, b_router_e, w1, w3, w2, g_ple, w_ple_gate, w_ple_proj, g_final):
    bt, s_len, d = x.shape
    for i in range(DEPTH):
        lam_init = 0.8 - 0.6 * math.exp(-0.3 * i)
        h = rms_norm(x, g_mix[i])
        z = h @ w_in[i]
        zq = z[..., :ATTN_WIDTH]
        zk = z[..., ATTN_WIDTH:2 * ATTN_WIDTH]
        zv = z[..., 2 * ATTN_WIDTH:3 * ATTN_WIDTH]
        zu = z[..., 3 * ATTN_WIDTH:]
        a = diff_attention(zq, zk, zv, rel_bias, lam_q1[i], lam_k1[i], lam_q2[i],
                           lam_k2[i], subln_g[i], lam_init)
        s = s5_ssm(zu, ssm_lam_re[i], ssm_lam_im[i], ssm_log_dt[i], ssm_b_re[i],
                   ssm_b_im[i], ssm_c_re[i], ssm_c_im[i], ssm_d[i])
        s = jax.nn.gelu(s)
        s = s * jax.nn.sigmoid(s @ w_glu[i] + b_glu[i])
        s = rms_norm(s, ssm_norm_g[i])
        x = x + jnp.concatenate([a, s], axis=-1) @ w_o[i]
        h = rms_norm(x, g_ffn[i]).reshape(bt * s_len, d)
        x = x + hier_moe(h, w_router_g[i], b_router_g[i], w_router_e[i], b_router_e[i],
                         w1[i], w3[i], w2[i]).reshape(bt, s_len, d)
        gate = jax.nn.sigmoid(rms_norm(x, g_ple[i]) @ w_ple_gate[i])
        x = x + gate * (p[i] @ w_ple_proj[i])
    return rms_norm(x, g_final)
```

```cpp
#include <hip/hip_runtime.h>
#include <cstdint>
#include <cmath>

namespace {
constexpr int BATCH = 4, SEQ = 4096, D = 2048, MT = BATCH * SEQ;
constexpr int AW = 1024, SW = 1024, NH = 8, DK = 64, DV = 128, PROJ = 4096;
constexpr int NBUCK = 32;
constexpr int SG = 16, SGN = 64, SP = 64;
constexpr int NEG = 4, EPG = 8, NE = 32, DE = 512;
constexpr int PLE = 256;
constexpr int ECAP = MT;

__device__ __forceinline__ float sigmoidf_(float x) { return 1.f / (1.f + __expf(-x)); }
__device__ __forceinline__ float gelu_tanh(float x) { const float c = 0.7978845608028654f; float u = c * (x + 0.044715f * x * x * x); return 0.5f * x * (1.f + tanhf(u)); }

__global__ void __launch_bounds__(256) k_rmsnorm(const float* in, int ld_in, const float* g, float* out, int ld_out, int n, float eps, float post) {
    __shared__ float red[4];
    const int row = blockIdx.x, t = threadIdx.x;
    const float* r = in + (size_t)row * ld_in;
    float s = 0.f;
    for (int i = t; i < n; i += 256) { float v = r[i]; s += v * v; }
    for (int o = 32; o > 0; o >>= 1) s += __shfl_xor(s, o);
    if ((t & 63) == 0) red[t >> 6] = s;
    __syncthreads();
    s = red[0] + red[1] + red[2] + red[3];
    const float rs = rsqrtf(s / (float)n + eps) * post;
    float* o_ = out + (size_t)row * ld_out;
    for (int i = t; i < n; i += 256) o_[i] = r[i] * rs * g[i];
}

template <class Epi>
__device__ __forceinline__ void sgemm_tile(const float* __restrict__ A, int lda, const int* __restrict__ rowidx, int nvalid,
                                           const float* __restrict__ B, int ldb, int K, int m0, int n0, const Epi& epi) {
    __shared__ float As[16][64 + 4];
    __shared__ float Bs[16][64 + 4];
    const int t = threadIdx.x, tx = t & 15, ty = t >> 4;
    float acc[4][4];
#pragma unroll
    for (int i = 0; i < 4; ++i)
#pragma unroll
        for (int j = 0; j < 4; ++j) acc[i][j] = 0.f;
    const int ar = t >> 2, ak = (t & 3) * 4;
    int arow;
    { const int lr = m0 + ar; arow = (lr < nvalid) ? (rowidx ? rowidx[lr] : lr) : -1; }
    const int bk = t >> 4, bn = (t & 15) * 4;
    for (int k0 = 0; k0 < K; k0 += 16) {
        float4 av = make_float4(0.f, 0.f, 0.f, 0.f);
        if (arow >= 0) av = *(const float4*)(A + (size_t)arow * lda + k0 + ak);
        const float4 bv = *(const float4*)(B + (size_t)(k0 + bk) * ldb + n0 + bn);
        __syncthreads();
        As[ak + 0][ar] = av.x; As[ak + 1][ar] = av.y; As[ak + 2][ar] = av.z; As[ak + 3][ar] = av.w;
        *(float4*)&Bs[bk][bn] = bv;
        __syncthreads();
#pragma unroll
        for (int kk = 0; kk < 16; ++kk) {
            const float4 a4 = *(const float4*)&As[kk][ty * 4];
            const float4 b4 = *(const float4*)&Bs[kk][tx * 4];
            const float a_[4] = {a4.x, a4.y, a4.z, a4.w}, b_[4] = {b4.x, b4.y, b4.z, b4.w};
#pragma unroll
            for (int i = 0; i < 4; ++i)
#pragma unroll
                for (int j = 0; j < 4; ++j) acc[i][j] += a_[i] * b_[j];
        }
    }
#pragma unroll
    for (int i = 0; i < 4; ++i) {
        const int lr = m0 + ty * 4 + i;
        if (lr < nvalid) {
#pragma unroll
            for (int j = 0; j < 4; ++j) epi(lr, n0 + tx * 4 + j, acc[i][j]);
        }
    }
}

struct EpiStore { float* C; int ldc; int pad; __device__ void operator()(int r, int c, float v) const { C[(size_t)r * ldc + c] = v; } };
struct EpiGlu { const float* s1; const float* b; float* s2; __device__ void operator()(int r, int c, float v) const { const float s = s1[(size_t)r * SW + c]; s2[(size_t)r * SW + c] = s * sigmoidf_(v + b[c]); } };
struct EpiRes { const float* x; float* o; __device__ void operator()(int r, int c, float v) const { o[(size_t)r * D + c] = x[(size_t)r * D + c] + v; } };
struct EpiGate { const float* pp; float* xio; __device__ void operator()(int r, int c, float v) const { const size_t i = (size_t)r * D + c; xio[i] = xio[i] + sigmoidf_(v) * pp[i]; } };

template <class Epi>
__global__ void __launch_bounds__(256) k_sgemm(const float* A, const float* B, int lda, int ldb, int K, int M, Epi epi) {
    sgemm_tile(A, lda, nullptr, M, B, ldb, K, blockIdx.y * 64, blockIdx.x * 64, epi);
}

__global__ void __launch_bounds__(64) k_attn(const float* __restrict__ z, const float* __restrict__ rel_bias, float* __restrict__ O  ) {
    __shared__ float Ks[64][64];
    __shared__ float Vs[64][128];
    __shared__ float lut[132];
    const int qt = blockIdx.x, hc = blockIdx.y, b = blockIdx.z, h = hc >> 1, c = hc & 1, t = threadIdx.x;
    for (int n = t; n < 132; n += 64) {
        int bucket;
        if (n < 16) bucket = n;
        else { const float nf = (float)n; int lg = 16 + (int)(logf(nf / 16.f) / 2.0794415416798357f * 16.f); bucket = lg < 31 ? lg : 31; }
        lut[n] = rel_bias[bucket * NH + h];
    }
    const int qrow = qt * 64 + t;
    const float* zrow = z + (size_t)(b * SEQ + qrow) * PROJ;
    float q[64];
#pragma unroll
    for (int i = 0; i < 64; ++i) q[i] = zrow[h * 128 + c * 64 + i] * 0.125f;
    float o[128];
#pragma unroll
    for (int i = 0; i < 128; ++i) o[i] = 0.f;
    float m = -1e30f, l = 0.f;
    for (int kt = 0; kt <= qt; ++kt) {
        __syncthreads();
        for (int i = t; i < 64 * 16; i += 64) { const int r = i >> 4, cc = (i & 15) * 4; *(float4*)&Ks[r][cc] = *(const float4*)(z + (size_t)(b * SEQ + kt * 64 + r) * PROJ + AW + h * 128 + c * 64 + cc); }
        for (int i = t; i < 64 * 32; i += 64) { const int r = i >> 5, cc = (i & 31) * 4; *(float4*)&Vs[r][cc] = *(const float4*)(z + (size_t)(b * SEQ + kt * 64 + r) * PROJ + 2 * AW + h * 128 + cc); }
        __syncthreads();
        const int jmax = (kt == qt) ? t : 63;
        for (int j = 0; j <= jmax; ++j) {
            float s = 0.f;
#pragma unroll
            for (int i = 0; i < 64; i += 4) { const float4 kv = *(const float4*)&Ks[j][i]; s += q[i] * kv.x + q[i + 1] * kv.y + q[i + 2] * kv.z + q[i + 3] * kv.w; }
            int dist = qrow - (kt * 64 + j); dist = dist > 131 ? 131 : dist;
            s += lut[dist];
            float p;
            if (s > m) { const float al = __expf(m - s); l = l * al + 1.f; m = s; p = 1.f;
#pragma unroll
                for (int i = 0; i < 128; ++i) o[i] *= al; }
            else { p = __expf(s - m); l += p; }
#pragma unroll
            for (int i = 0; i < 128; i += 4) { const float4 vv = *(const float4*)&Vs[j][i]; o[i] += p * vv.x; o[i + 1] += p * vv.y; o[i + 2] += p * vv.z; o[i + 3] += p * vv.w; }
        }
    }
    const float il = 1.f / l;
    float* orow = O + (size_t)(b * SEQ + qrow) * D + c * 1024 + h * 128;
#pragma unroll
    for (int i = 0; i < 128; i += 4) *(float4*)(orow + i) = make_float4(o[i] * il, o[i + 1] * il, o[i + 2] * il, o[i + 3] * il);
}

__global__ void __launch_bounds__(256) k_attn_combine(float* scat, const float* lq1, const float* lk1, const float* lq2, const float* lk2, const float* subg) {
    const int t = threadIdx.x, lane = t & 63, w = t >> 6;
    float a = lq1[lane] * lk1[lane], bq = lq2[lane] * lk2[lane];
    for (int o = 32; o > 0; o >>= 1) { a += __shfl_xor(a, o); bq += __shfl_xor(bq, o); }
    const float lam = __expf(a) - __expf(bq) + 0.2f;
    const int pair = blockIdx.x * 4 + w, tok = pair >> 3, h = pair & 7;
    float* r1 = scat + (size_t)tok * D + h * 128; const float* r2 = r1 + 1024;
    const float v0 = r1[lane] - lam * r2[lane], v1 = r1[lane + 64] - lam * r2[lane + 64];
    float s = v0 * v0 + v1 * v1;
    for (int o = 32; o > 0; o >>= 1) s += __shfl_xor(s, o);
    const float rs = rsqrtf(s / 128.f + 1e-5f) * 0.8f;
    __syncthreads();
    r1[lane] = v0 * rs * subg[lane]; r1[lane + 64] = v1 * rs * subg[lane + 64];
}

__global__ void __launch_bounds__(64) k_ssm(const float* __restrict__ z, const float* lam_re, const float* lam_im, const float* log_dt, const float* b_re, const float* b_im,
                                            const float* c_re, const float* c_im, const float* dsk, float* __restrict__ s1  ) {
    __shared__ float us[16][16];
    __shared__ float xs[16][128];
    __shared__ float cre[16][64], cim[16][64];
    __shared__ float dd[16];
    const int g = blockIdx.x, b = blockIdx.y, p = threadIdx.x;
    const float lre = lam_re[g * SP + p], lim = lam_im[g * SP + p], dt = expf(log_dt[g]);
    const float mag = expf(lre * dt), ar = mag * cosf(lim * dt), ai = mag * sinf(lim * dt);
    const float den = lre * lre + lim * lim, nr = ar - 1.f, ni = ai;
    const float cr = (nr * lre + ni * lim) / den, ci = (ni * lre - nr * lim) / den;
    float bbr[16], bbi[16];
#pragma unroll
    for (int h = 0; h < 16; ++h) { const float br = b_re[(g * SP + p) * SG + h], bi = b_im[(g * SP + p) * SG + h]; bbr[h] = cr * br - ci * bi; bbi[h] = cr * bi + ci * br; }
    for (int i = p; i < 16 * 64; i += 64) { cre[i >> 6][i & 63] = c_re[g * SG * SP + i]; cim[i >> 6][i & 63] = c_im[g * SG * SP + i]; }
    if (p < 16) dd[p] = dsk[g * SG + p];
    float xr = 0.f, xi = 0.f;
    for (int ch = 0; ch < SEQ / 16; ++ch) {
        __syncthreads();
        { const int tt = p >> 2, hh = (p & 3) * 4; *(float4*)&us[tt][hh] = *(const float4*)(z + (size_t)(b * SEQ + ch * 16 + tt) * PROJ + 3 * AW + g * SG + hh); }
        __syncthreads();
#pragma unroll
        for (int tt = 0; tt < 16; ++tt) {
            float bur = 0.f, bui = 0.f;
#pragma unroll
            for (int h = 0; h < 16; ++h) { const float u = us[tt][h]; bur += bbr[h] * u; bui += bbi[h] * u; }
            const float nxr = ar * xr - ai * xi + bur, nxi = ar * xi + ai * xr + bui;
            xr = nxr; xi = nxi;
            xs[tt][p] = xr; xs[tt][64 + p] = xi;
        }
        __syncthreads();
#pragma unroll
        for (int j = 0; j < 4; ++j) {
            const int idx = p * 4 + j, tt = idx >> 4, h = idx & 15;
            float y = 0.f;
            for (int pp = 0; pp < 64; ++pp) y += xs[tt][pp] * cre[h][pp] - xs[tt][64 + pp] * cim[h][pp];
            y += dd[h] * us[tt][h];
            s1[(size_t)(b * SEQ + ch * 16 + tt) * SW + g * SG + h] = gelu_tanh(y);
        }
    }
}

__global__ void __launch_bounds__(256) k_router(const float* __restrict__ h, const float* w_rg, const float* b_rg, const float* w_re, const float* b_re,
                                                int* counts, int* row_tok, float* row_w) {
    const int t = threadIdx.x, lane = t & 63, w = t >> 6, tok = blockIdx.x * 4 + w;
    const float* hr = h + (size_t)tok * D;
    float acc[36];
#pragma unroll
    for (int j = 0; j < 36; ++j) acc[j] = 0.f;
    for (int k = lane; k < D; k += 64) {
        const float hv = hr[k];
#pragma unroll
        for (int j = 0; j < 4; ++j) acc[j] += hv * w_rg[k * NEG + j];
#pragma unroll
        for (int j = 0; j < 32; ++j) acc[4 + j] += hv * w_re[k * NE + j];
    }
#pragma unroll
    for (int j = 0; j < 36; ++j) for (int o = 32; o > 0; o >>= 1) acc[j] += __shfl_xor(acc[j], o);
    if (lane == 0) {
        float lg0 = acc[0] + b_rg[0], lg1 = acc[1] + b_rg[1], lg2 = acc[2] + b_rg[2], lg3 = acc[3] + b_rg[3];
        int gs = 0; float lm = lg0;
        if (lg1 > lm) { lm = lg1; gs = 1; }
        if (lg2 > lm) { lm = lg2; gs = 2; }
        if (lg3 > lm) { lm = lg3; gs = 3; }
        const float se = __expf(lg0 - lm) + __expf(lg1 - lm) + __expf(lg2 - lm) + __expf(lg3 - lm);
        const float gate_g = 1.f / se;
        float le[8];
#pragma unroll
        for (int j = 0; j < 8; ++j) {
            const float a = gs == 0 ? acc[4 + j] : gs == 1 ? acc[12 + j] : gs == 2 ? acc[20 + j] : acc[28 + j];
            le[j] = a + b_re[gs * 8 + j];
        }
        int i0 = 0; float m0 = le[0];
#pragma unroll
        for (int j = 1; j < 8; ++j) if (le[j] > m0) { m0 = le[j]; i0 = j; }
        int i1 = -1; float m1 = -3.0e38f;
#pragma unroll
        for (int j = 0; j < 8; ++j) if (j != i0 && le[j] > m1) { m1 = le[j]; i1 = j; }
        const float p0 = 1.f, p1 = __expf(m1 - m0);
        const float w0 = gate_g * p0 / (p0 + p1), w1 = gate_g * p1 / (p0 + p1);
        const int e0 = gs * 8 + i0, e1 = gs * 8 + i1;
        const int pos0 = atomicAdd(&counts[e0], 1); row_tok[e0 * ECAP + pos0] = tok; row_w[e0 * ECAP + pos0] = w0;
        const int pos1 = atomicAdd(&counts[e1], 1); row_tok[e1 * ECAP + pos1] = tok; row_w[e1 * ECAP + pos1] = w1;
    }
}

__device__ __forceinline__ int expert_base(const int* counts, int e) { int s = 0; for (int i = 0; i < e; ++i) s += (counts[i] + 63) & ~63; return s; }
struct EpiUp1 { float* hm; int base; __device__ void operator()(int r, int c, float v) const { hm[(size_t)(base + r) * DE + c] = v * sigmoidf_(v); } };
struct EpiUp3 { float* hm; int base; __device__ void operator()(int r, int c, float v) const { hm[(size_t)(base + r) * DE + c] *= v; } };
struct EpiDown { float* xo; const int* tk; const float* wt; __device__ void operator()(int r, int c, float v) const { atomicAdd(&xo[(size_t)tk[r] * D + c], wt[r] * v); } };

template <int WHICH>
__global__ void __launch_bounds__(256) k_moe_up(const float* h2, const float* w13, const int* counts, const int* row_tok, float* hmid) {
    const int e = blockIdx.z, cnt = counts[e], m0 = blockIdx.y * 64;
    if (m0 >= cnt) return;
    const int base = expert_base(counts, e);
    if (WHICH == 1) { EpiUp1 ep{hmid, base}; sgemm_tile(h2, D, row_tok + e * ECAP, cnt, w13 + (size_t)e * D * DE, DE, D, m0, blockIdx.x * 64, ep); }
    else { EpiUp3 ep{hmid, base}; sgemm_tile(h2, D, row_tok + e * ECAP, cnt, w13 + (size_t)e * D * DE, DE, D, m0, blockIdx.x * 64, ep); }
}
__global__ void __launch_bounds__(256) k_moe_down(const float* hmid, const float* w2, const int* counts, const int* row_tok, const float* row_w, float* xo) {
    const int e = blockIdx.z, cnt = counts[e], m0 = blockIdx.y * 64;
    if (m0 >= cnt) return;
    const int base = expert_base(counts, e);
    EpiDown ep{xo, row_tok + e * ECAP, row_w + e * ECAP};
    sgemm_tile(hmid + (size_t)base * DE, DE, nullptr, cnt, w2 + (size_t)e * DE * D, D, DE, m0, blockIdx.x * 64, ep);
}
}

extern "C" void kernel_launch(void* const* d_in, const int* in_sizes, int n_in, void* d_out, int out_size, void* d_ws, size_t ws_size, hipStream_t stream) {
    const float* x = (const float*)d_in[0];      const float* p = (const float*)d_in[1];      const float* rel_bias = (const float*)d_in[2];
    const float* g_mix = (const float*)d_in[3];  const float* w_in = (const float*)d_in[4];
    const float* lq1 = (const float*)d_in[5], *lk1 = (const float*)d_in[6], *lq2 = (const float*)d_in[7], *lk2 = (const float*)d_in[8];
    const float* subln_g = (const float*)d_in[9];
    const float* s_lre = (const float*)d_in[10], *s_lim = (const float*)d_in[11], *s_ldt = (const float*)d_in[12], *s_bre = (const float*)d_in[13], *s_bim = (const float*)d_in[14];
    const float* s_cre = (const float*)d_in[15], *s_cim = (const float*)d_in[16], *s_d = (const float*)d_in[17];
    const float* w_glu = (const float*)d_in[18], *b_glu = (const float*)d_in[19], *ssm_norm_g = (const float*)d_in[20], *w_o = (const float*)d_in[21], *g_ffn = (const float*)d_in[22];
    const float* w_rg = (const float*)d_in[23], *b_rg = (const float*)d_in[24], *w_re = (const float*)d_in[25], *b_re = (const float*)d_in[26];
    const float* w1 = (const float*)d_in[27], *w3 = (const float*)d_in[28], *w2 = (const float*)d_in[29];
    const float* g_ple = (const float*)d_in[30], *w_pg = (const float*)d_in[31], *w_pp = (const float*)d_in[32], *g_final = (const float*)d_in[33];
    float* out = (float*)d_out;
    char* ws = (char*)d_ws;
    const size_t MiB = 1u << 20;
    int* counts = (int*)ws;
    int* row_tok = (int*)(ws + 1 * MiB);
    float* row_w = (float*)(ws + 3 * MiB);
    float* R0 = (float*)(ws + 8 * MiB);
    float* R1 = (float*)(ws + 136 * MiB);
    float* R5 = (float*)(ws + 392 * MiB);
    float* R6 = (float*)(ws + 456 * MiB);
    float* z = R1; float* hmid = R1; float* pp = R1 + (size_t)18 * 1024 * 1024;

    (void)hipMemsetAsync(counts, 0, 256, stream);
    k_rmsnorm<<<MT, 256, 0, stream>>>(x, D, g_mix, R0, D, D, 1e-6f, 1.f);
    k_sgemm<EpiStore><<<dim3(PROJ / 64, MT / 64), 256, 0, stream>>>(R0, w_in, D, PROJ, D, MT, EpiStore{z, PROJ, 0});
    k_attn<<<dim3(SEQ / 64, NH * 2, BATCH), 64, 0, stream>>>(z, rel_bias, R0);
    k_attn_combine<<<MT * NH / 4, 256, 0, stream>>>(R0, lq1, lk1, lq2, lk2, subln_g);
    k_ssm<<<dim3(SGN, BATCH), 64, 0, stream>>>(z, s_lre, s_lim, s_ldt, s_bre, s_bim, s_cre, s_cim, s_d, R5);
    k_sgemm<EpiGlu><<<dim3(SW / 64, MT / 64), 256, 0, stream>>>(R5, w_glu, SW, SW, SW, MT, EpiGlu{R5, b_glu, R6});
    k_rmsnorm<<<MT, 256, 0, stream>>>(R6, SW, ssm_norm_g, R0 + 1024, D, SW, 1e-6f, 1.f);
    k_sgemm<EpiRes><<<dim3(D / 64, MT / 64), 256, 0, stream>>>(R0, w_o, D, D, D, MT, EpiRes{x, out});
    k_rmsnorm<<<MT, 256, 0, stream>>>(out, D, g_ffn, R0, D, D, 1e-6f, 1.f);
    k_router<<<MT / 4, 256, 0, stream>>>(R0, w_rg, b_rg, w_re, b_re, counts, row_tok, row_w);
    k_moe_up<1><<<dim3(DE / 64, MT / 64, NE), 256, 0, stream>>>(R0, w1, counts, row_tok, hmid);
    k_moe_up<3><<<dim3(DE / 64, MT / 64, NE), 256, 0, stream>>>(R0, w3, counts, row_tok, hmid);
    k_moe_down<<<dim3(D / 64, MT / 64, NE), 256, 0, stream>>>(hmid, w2, counts, row_tok, row_w, out);
    k_sgemm<EpiStore><<<dim3(D / 64, MT / 64), 256, 0, stream>>>(p, w_pp, PLE, D, PLE, MT, EpiStore{pp, D, 0});
    k_rmsnorm<<<MT, 256, 0, stream>>>(out, D, g_ple, R0, D, D, 1e-6f, 1.f);
    k_sgemm<EpiGate><<<dim3(D / 64, MT / 64), 256, 0, stream>>>(R0, w_pg, D, D, D, MT, EpiGate{pp, out});
    k_rmsnorm<<<MT, 256, 0, stream>>>(out, D, g_final, out, D, D, 1e-6f, 1.f);
}
```

```cpp
#include <hip/hip_runtime.h>
#include <hip/hip_bf16.h>
#include <cstdio>
#include <cstdint>
#include <cmath>
namespace pg8 {
#define PG8_LAS __attribute__((address_space(3)))
typedef unsigned short bf16_t;
typedef short bf16x8 __attribute__((ext_vector_type(8)));
typedef float f32x4 __attribute__((ext_vector_type(4)));
typedef float f32x2 __attribute__((ext_vector_type(2)));
typedef unsigned u32x4 __attribute__((ext_vector_type(4)));
constexpr int BM = 256, BK = 64, HALF = 128, HTB = HALF * BK * 2  , STAGE_BYTES = 8 * HTB, NXCD = 8, WGM = 8;

__host__ __device__ __forceinline__ int lds_byte(int r, int c) { const int st = (r >> 4) * 2 + (c >> 5), rr = r & 15, cc = c & 31, ob = rr * 64 + cc * 2; return st * 1024 + (ob ^ (((ob >> 9) & 1) << 5)); }
__host__ __device__ __forceinline__ void stage_rc(int b, int& R, int& C) { const int st = b / 1024, sb = b % 1024, swz = sb ^ (((sb >> 9) & 1) << 5); R = (st >> 1) * 16 + swz / 64; C = (st & 1) * 32 + (swz % 64) / 2; }
__host__ __device__ __forceinline__ int perm32(int rho) { const int n = rho >> 4, i = rho & 15; return 8 * (i >> 2) + 4 * n + (i & 3); }

struct Unit { const char* A; const char* B; const int* rows; int pm, pn, x0, x1; };

struct DenseOrder {
    const char* A; const char* Bt; int lda2, ldb2  , nM, nN, nwg, G, c;
    __device__ __forceinline__ void init(const void* A_, const void* Bt_, int lda, int ldb, int M, int N, int G_, int c_) { A = (const char*)A_; Bt = (const char*)Bt_; lda2 = lda * 2; ldb2 = ldb * 2; nM = M / BM; nN = N / BM; nwg = nM * nN; G = G_; c = c_; }
    __device__ __forceinline__ bool next(int i, Unit& u) const {
        const long L = (long)i * G + c; if (L >= nwg) return false;
        int wgid = (int)L; { const int q = nwg / NXCD, r = nwg % NXCD, xcd = wgid % NXCD, off = wgid / NXCD; wgid = (xcd < r ? xcd * (q + 1) : r * (q + 1) + (xcd - r) * q) + off; }
        const int nig = WGM * nN, gid = wgid / nig, fm = gid * WGM, gsz = (nM - fm) < WGM ? (nM - fm) : WGM;
        u.pm = fm + ((wgid % nig) % gsz); u.pn = (wgid % nig) / gsz;
        u.A = A + (size_t)u.pm * BM * lda2; u.B = Bt + (size_t)u.pn * BM * ldb2; u.rows = nullptr; u.x0 = 0; u.x1 = 0; return true;
    }
};

__device__ __forceinline__ unsigned cvt_pk_bf16(float lo, float hi) { unsigned r; asm volatile("v_cvt_pk_bf16_f32 %0, %1, %2" : "=v"(r) : "v"(lo), "v"(hi)); return r; }
__device__ __forceinline__ float bf_lo(unsigned w) { return __builtin_bit_cast(float, w << 16); }
__device__ __forceinline__ float bf_hi(unsigned w) { return __builtin_bit_cast(float, w & 0xffff0000u); }
__device__ __forceinline__ float fast_sigmoid(float x) { return __builtin_amdgcn_rcpf(1.0f + __builtin_amdgcn_exp2f(-1.4426950408889634f * x)); }
__device__ __forceinline__ float gelu_tanh_f(float x) { const float u2 = 1.5957691216057308f * (x + 0.044715f * x * x * x); return x * fast_sigmoid(u2); }

template <class Epi, class Sched, bool ALIGN_EPI, bool GATHER>
__device__ __forceinline__ void gemm_phase(PG8_LAS unsigned char* lds, const int K, const int lda, const int ldb, const Sched& S, const Epi& E) {
    const int tid = threadIdx.x, wid = __builtin_amdgcn_readfirstlane(tid >> 6), lane = tid & 63, wr = wid >> 2, wc = wid & 3, fr = lane & 15, fq = lane >> 4;
    int nt = K / BK; asm volatile("" : "+s"(nt));
    int sR[2], sC[2];
    unsigned voffA[2][2], nvoffA[2][2], voffB[2];
#pragma unroll
    for (int i = 0; i < 2; ++i) { int R, C; stage_rc(tid * 16 + i * 8192, R, C); sR[i] = R; sC[i] = C; const int Rb = (R & ~31) + perm32(R & 31); voffB[i] = (unsigned)(Rb * ldb + C) * 2u; }
    const size_t kstep = (size_t)(BK * 2);
    const size_t hstepB = (size_t)HALF * ldb * 2;
    const unsigned ldsw = (unsigned)wid * 1024u;
    const int aoff = lds_byte(wr * 64 + fr, fq * 8), boff = lds_byte(wc * 32 + fr, fq * 8);
#define PG8_SA(b, h) (((b) * 2 + (h)) * HTB)
#define PG8_SB(b, h) ((4 + (b) * 2 + (h)) * HTB)
#define PG8_STAGE(bufoff, gbase, voff) do { _Pragma("unroll") for (int _i = 0; _i < 2; ++_i) \
        __builtin_amdgcn_global_load_lds((const unsigned*)((const char*)(gbase) + (voff)[_i]), (PG8_LAS unsigned*)(lds + (bufoff) + ldsw + _i * 8192), 16, 0, 0); } while (0)
#define PG8_LDA(dst, b, h) do { _Pragma("unroll") for (int m = 0; m < 4; ++m) _Pragma("unroll") for (int k = 0; k < 2; ++k) dst[m][k] = *(const PG8_LAS bf16x8*)(lds + PG8_SA(b, h) + aoff + m * 2048 + k * 1024); } while (0)
#define PG8_LDB(dst, b, h) do { _Pragma("unroll") for (int n = 0; n < 2; ++n) _Pragma("unroll") for (int k = 0; k < 2; ++k) dst[n][k] = *(const PG8_LAS bf16x8*)(lds + PG8_SB(b, h) + boff + n * 2048 + k * 1024); } while (0)
#define PG8_MMA(ai, bj, At, Bt) do { __builtin_amdgcn_s_setprio(1); _Pragma("unroll") for (int m = 0; m < 4; ++m) _Pragma("unroll") for (int n = 0; n < 2; ++n) _Pragma("unroll") for (int k = 0; k < 2; ++k) \
        acc[ai][bj][m][n] = __builtin_amdgcn_mfma_f32_16x16x32_bf16(Bt[n][k], At[m][k], acc[ai][bj][m][n], 0, 0, 0); __builtin_amdgcn_s_setprio(0); } while (0)
#define PG8_WAIT_V(n) asm volatile("s_waitcnt vmcnt(" #n ")" ::: "memory")
#define PG8_WAIT_L(n) asm volatile("s_waitcnt lgkmcnt(" #n ")" ::: "memory")
#define PG8_BAR __builtin_amdgcn_s_barrier()
#define PG8_SCHED __builtin_amdgcn_sched_barrier(0)
#define PG8_VOFF(dst, u) do { _Pragma("unroll") for (int _h = 0; _h < 2; ++_h) _Pragma("unroll") for (int _i = 0; _i < 2; ++_i) { \
        int _row = sR[_i] + _h * HALF; if constexpr (GATHER) _row = S.arow(u, _row); dst[_h][_i] = (unsigned)(_row * lda + sC[_i]) * 2u; } } while (0)
    Unit cur, nxt; int ui = 0;
    if (!S.next(0, cur)) return;
    f32x4 acc[2][2][4][2];
#pragma unroll
    for (int a = 0; a < 2; ++a)
#pragma unroll
        for (int b = 0; b < 2; ++b)
#pragma unroll
            for (int m = 0; m < 4; ++m)
#pragma unroll
                for (int n = 0; n < 2; ++n) acc[a][b][m][n] = (f32x4){0.f, 0.f, 0.f, 0.f};
    bf16x8 At[4][2], B0[2][2], B1[2][2];
    PG8_VOFF(voffA, cur);
    const char* cA = cur.A; const char* cB = cur.B;
    PG8_STAGE(PG8_SB(0, 0), cB, voffB); PG8_STAGE(PG8_SB(0, 1), cB + hstepB, voffB); PG8_STAGE(PG8_SA(0, 0), cA, voffA[0]); PG8_STAGE(PG8_SA(0, 1), cA, voffA[1]);
    if (wr == 1) PG8_BAR;
    PG8_WAIT_V(2); PG8_BAR;
    PG8_STAGE(PG8_SB(1, 0), cB + kstep, voffB); PG8_STAGE(PG8_SA(1, 0), cA + kstep, voffA[0]); PG8_STAGE(PG8_SB(1, 1), cB + hstepB + kstep, voffB);
    PG8_WAIT_V(6); PG8_BAR;
    for (;;) {
        const bool has_next = S.next(ui + 1, nxt);
        if constexpr (GATHER) { if (has_next) { PG8_VOFF(nvoffA, nxt); } else {
#pragma unroll
            for (int h = 0; h < 2; ++h)
#pragma unroll
                for (int i = 0; i < 2; ++i) nvoffA[h][i] = voffA[h][i]; } }
        else {
#pragma unroll
            for (int h = 0; h < 2; ++h)
#pragma unroll
                for (int i = 0; i < 2; ++i) nvoffA[h][i] = voffA[h][i]; }
        const char* nA = has_next ? nxt.A : cA; const char* nB = has_next ? nxt.B : cB;
        for (int t = 0; t < nt; t += 2) {
            const bool last = (t == nt - 2);
            const char* a1 = cA + (size_t)(t + 1) * kstep;
            const char* a2 = last ? nA : cA + (size_t)(t + 2) * kstep; const char* b2 = last ? nB : cB + (size_t)(t + 2) * kstep;
            const char* a3 = a2 + kstep; const char* b3 = b2 + kstep;
            unsigned v2[2][2];
#pragma unroll
            for (int h = 0; h < 2; ++h)
#pragma unroll
                for (int i = 0; i < 2; ++i) v2[h][i] = last ? nvoffA[h][i] : voffA[h][i];
            E.khook(acc, cur, t, nt, wr, fr);
            PG8_LDB(B0, 0, 0); PG8_LDB(B1, 0, 1); PG8_SCHED; PG8_LDA(At, 0, 0); PG8_STAGE(PG8_SA(1, 1), a1, voffA[1]);
            PG8_WAIT_V(8); PG8_WAIT_L(0); PG8_BAR; PG8_MMA(0, 0, At, B0); PG8_MMA(0, 1, At, B1); PG8_BAR; PG8_SCHED;
            PG8_LDA(At, 0, 1); PG8_STAGE(PG8_SB(0, 0), b2, voffB); PG8_STAGE(PG8_SB(0, 1), b2 + hstepB, voffB); PG8_STAGE(PG8_SA(0, 0), a2, v2[0]);
            PG8_WAIT_V(8); PG8_WAIT_L(0); PG8_BAR; PG8_MMA(1, 0, At, B0); PG8_MMA(1, 1, At, B1); PG8_BAR; PG8_SCHED;
            PG8_LDB(B0, 1, 0); PG8_LDB(B1, 1, 1); PG8_SCHED; PG8_LDA(At, 1, 0); PG8_STAGE(PG8_SA(0, 1), a2, v2[1]);
            PG8_WAIT_V(8); PG8_WAIT_L(0); PG8_BAR; PG8_MMA(0, 0, At, B0); PG8_MMA(0, 1, At, B1); PG8_BAR; PG8_SCHED;
            PG8_LDA(At, 1, 1); PG8_STAGE(PG8_SB(1, 0), b3, voffB); PG8_STAGE(PG8_SB(1, 1), b3 + hstepB, voffB); PG8_STAGE(PG8_SA(1, 0), a3, v2[0]);
            PG8_WAIT_V(8); PG8_WAIT_L(0); PG8_BAR; PG8_MMA(1, 0, At, B0); PG8_MMA(1, 1, At, B1); PG8_BAR; PG8_SCHED;
        }
        if constexpr (ALIGN_EPI) { if (wr == 0) PG8_BAR; }
        if constexpr (!Epi::AFTER_DRAIN) { E(acc, cur, wr, wc, fr, fq); }
        if (!has_next) break;
#pragma unroll
        for (int a = 0; a < 2; ++a)
#pragma unroll
            for (int b = 0; b < 2; ++b)
#pragma unroll
                for (int m = 0; m < 4; ++m)
#pragma unroll
                    for (int n = 0; n < 2; ++n) acc[a][b][m][n] = (f32x4){0.f, 0.f, 0.f, 0.f};
        cur = nxt; cA = nA; cB = nB; ++ui;
#pragma unroll
        for (int h = 0; h < 2; ++h)
#pragma unroll
            for (int i = 0; i < 2; ++i) voffA[h][i] = nvoffA[h][i];
        if constexpr (ALIGN_EPI) { if (wr == 1) PG8_BAR; }
    }
    PG8_WAIT_V(0);
    if constexpr (!ALIGN_EPI) { if (wr == 0) PG8_BAR; }
    PG8_BAR;
    if constexpr (Epi::AFTER_DRAIN) { E.fused(acc, cur, wr, wc, fr, fq, lds); }
#undef PG8_SA
#undef PG8_SB
#undef PG8_STAGE
#undef PG8_LDA
#undef PG8_LDB
#undef PG8_MMA
#undef PG8_WAIT_V
#undef PG8_WAIT_L
#undef PG8_BAR
#undef PG8_SCHED
#undef PG8_VOFF
}
}
namespace pg8 {
struct EpiBase {
    static constexpr bool AFTER_DRAIN = false;
    __device__ __forceinline__ void khook(f32x4 (&)[2][2][4][2], const Unit&, int, int, int, int) const {}
};
#define EPI_LOOP_ROWS for (int ai = 0; ai < 2; ++ai) _Pragma("unroll") for (int m = 0; m < 4; ++m)
__device__ __forceinline__ u32x4 pack8(const f32x4 v0, const f32x4 v1) { u32x4 w; w.x = cvt_pk_bf16(v0[0], v0[1]); w.y = cvt_pk_bf16(v0[2], v0[3]); w.z = cvt_pk_bf16(v1[0], v1[1]); w.w = cvt_pk_bf16(v1[2], v1[3]); return w; }

struct EpiZ : EpiBase {
    bf16_t* Q; bf16_t* Ue; const float* r0; float c2;
    __device__ __forceinline__ void operator()(const f32x4 (&acc)[2][2][4][2], const Unit& u, int wr, int wc, int fr, int fq) const {
        const int sect = u.pn >> 2, colt = (u.pn & 3) * BM, row0 = u.pm * BM + wr * 64 + fr;
        bf16_t* base = Q + (size_t)sect * 16384 * 1024;
        const float sc = sect == 0 ? c2 : 1.f;
#pragma unroll
        EPI_LOOP_ROWS { const int row = row0 + ai * HALF + m * 16; const float rs = r0[row] * sc;
#pragma unroll
            for (int bj = 0; bj < 2; ++bj) { const int col = colt + bj * HALF + wc * 32 + 8 * fq;
                const u32x4 w = pack8(acc[ai][bj][m][0] * rs, acc[ai][bj][m][1] * rs);
                if (sect < 3) *(u32x4*)(base + (size_t)row * 1024 + col) = w;
                else { const int g = col >> 4, half = (col >> 3) & 1, b = row >> 12, t = row & 4095, c = t >> 4, j = t & 15;
                       *(u32x4*)(Ue + ((size_t)((g * 4 + b) * 256 + c) * 384 + j * 16 + half * 8)) = w; } } }
    }
};
struct EpiE {
    static constexpr bool AFTER_DRAIN = true;
    __device__ __forceinline__ void khook(f32x4 (&)[2][2][4][2], const Unit&, int, int, int, int) const {}
    __device__ __forceinline__ void fused(const f32x4 (&acc)[2][2][4][2], const Unit&, int wr, int wc, int fr, int fq, PG8_LAS unsigned char* lds) const {
        PG8_LAS float* Eo = (PG8_LAS float*)lds;
#pragma unroll
        EPI_LOOP_ROWS { const int row = wr * 64 + fr + ai * HALF + m * 16; const int col = wc * 32 + 8 * fq;
            *(PG8_LAS f32x4*)(Eo + row * 128 + col) = acc[ai][0][m][0]; *(PG8_LAS f32x4*)(Eo + row * 128 + col + 4) = acc[ai][0][m][1]; }
    }
};
struct EpiY : EpiBase {
    bf16_t* s1;
    __device__ __forceinline__ void operator()(const f32x4 (&acc)[2][2][4][2], const Unit& u, int wr, int wc, int fr, int fq) const {
        const int g = u.x0, b = u.x1;
#pragma unroll
        EPI_LOOP_ROWS { const int c = wr * 64 + fr + ai * HALF + m * 16;
#pragma unroll
            for (int bj = 0; bj < 2; ++bj) { const int col = bj * HALF + wc * 32 + 8 * fq, i = col >> 4, h0 = col & 15;
                f32x4 v0 = acc[ai][bj][m][0], v1 = acc[ai][bj][m][1];
#pragma unroll
                for (int q = 0; q < 4; ++q) { v0[q] = gelu_tanh_f(v0[q]); v1[q] = gelu_tanh_f(v1[q]); }
                *(u32x4*)(s1 + (size_t)(b * 4096 + c * 16 + i) * 1024 + g * 16 + h0) = pack8(v0, v1); } }
    }
};
struct EpiGlu : EpiBase {
    const bf16_t* s1; const float* bias; bf16_t* scat;
    __device__ __forceinline__ void operator()(const f32x4 (&acc)[2][2][4][2], const Unit& u, int wr, int wc, int fr, int fq) const {
        const int row0 = u.pm * BM + wr * 64 + fr, col0 = u.pn * BM + wc * 32 + 8 * fq;
        f32x4 bv[2][2];
#pragma unroll
        for (int bj = 0; bj < 2; ++bj)
#pragma unroll
            for (int n = 0; n < 2; ++n) bv[bj][n] = *(const f32x4*)(bias + col0 + bj * HALF + 4 * n);
#pragma unroll
        EPI_LOOP_ROWS { const int row = row0 + ai * HALF + m * 16;
#pragma unroll
            for (int bj = 0; bj < 2; ++bj) { const int col = col0 + bj * HALF;
                const u32x4 sv = *(const u32x4*)(s1 + (size_t)row * 1024 + col);
                f32x4 v0 = acc[ai][bj][m][0] + bv[bj][0], v1 = acc[ai][bj][m][1] + bv[bj][1];
                v0[0] = bf_lo(sv.x) * fast_sigmoid(v0[0]); v0[1] = bf_hi(sv.x) * fast_sigmoid(v0[1]); v0[2] = bf_lo(sv.y) * fast_sigmoid(v0[2]); v0[3] = bf_hi(sv.y) * fast_sigmoid(v0[3]);
                v1[0] = bf_lo(sv.z) * fast_sigmoid(v1[0]); v1[1] = bf_hi(sv.z) * fast_sigmoid(v1[1]); v1[2] = bf_lo(sv.w) * fast_sigmoid(v1[2]); v1[3] = bf_hi(sv.w) * fast_sigmoid(v1[3]);
                *(u32x4*)(scat + (size_t)row * 2048 + col) = pack8(v0, v1); } }
    }
};
struct EpiRes1 : EpiBase {
    const float* x; bf16_t* x1b; float* ssq;
    __device__ __forceinline__ void operator()(const f32x4 (&acc)[2][2][4][2], const Unit& u, int wr, int wc, int fr, int fq) const {
        const int row0 = u.pm * BM + wr * 64 + fr, col0 = u.pn * BM + wc * 32 + 8 * fq;
#pragma unroll
        EPI_LOOP_ROWS { const int row = row0 + ai * HALF + m * 16; float s = 0.f;
#pragma unroll
            for (int bj = 0; bj < 2; ++bj) { const size_t off = (size_t)row * 2048 + col0 + bj * HALF;
                const f32x4 v0 = acc[ai][bj][m][0] + *(const f32x4*)(x + off), v1 = acc[ai][bj][m][1] + *(const f32x4*)(x + off + 4);
                s += (v0[0] * v0[0] + v0[1] * v0[1]) + (v0[2] * v0[2] + v0[3] * v0[3]) + (v1[0] * v1[0] + v1[1] * v1[1]) + (v1[2] * v1[2] + v1[3] * v1[3]);
                *(u32x4*)(x1b + off) = pack8(v0, v1); }
            s += __shfl_xor(s, 16); s += __shfl_xor(s, 32);
            if (fq == 0) ssq[(size_t)row * 32 + u.pn * 4 + wc] = s; }
    }
};
struct EpiPP : EpiBase {
    bf16_t* pp;
    __device__ __forceinline__ void operator()(const f32x4 (&acc)[2][2][4][2], const Unit& u, int wr, int wc, int fr, int fq) const {
        const int row0 = u.pm * BM + wr * 64 + fr, col0 = u.pn * BM + wc * 32 + 8 * fq;
#pragma unroll
        EPI_LOOP_ROWS { const int row = row0 + ai * HALF + m * 16;
#pragma unroll
            for (int bj = 0; bj < 2; ++bj) *(u32x4*)(pp + (size_t)row * 2048 + col0 + bj * HALF) = pack8(acc[ai][bj][m][0], acc[ai][bj][m][1]); }
    }
};
struct EpiUp : EpiBase {
    const float* row_r; bf16_t* hmid;
    __device__ __forceinline__ void operator()(const f32x4 (&acc)[2][2][4][2], const Unit& u, int wr, int wc, int fr, int fq) const {
        const int rl0 = wr * 64 + fr, col = u.pn * HALF + wc * 32 + 8 * fq;
#pragma unroll
        EPI_LOOP_ROWS { const int rl = rl0 + ai * HALF + m * 16; const float r = row_r[u.x0 + rl];
            f32x4 o0, o1;
#pragma unroll
            for (int q = 0; q < 4; ++q) { const float a = acc[ai][0][m][0][q] * r, b = acc[ai][1][m][0][q] * r; o0[q] = a * fast_sigmoid(a) * b;
                                          const float c = acc[ai][0][m][1][q] * r, d = acc[ai][1][m][1][q] * r; o1[q] = c * fast_sigmoid(c) * d; }
            *(u32x4*)(hmid + (size_t)(u.x1 * BM + rl) * 512 + col) = pack8(o0, o1); }
    }
};
struct EpiDown : EpiBase {
    const int* row_ts; const float* row_w; bf16_t* contrib;
    __device__ __forceinline__ void operator()(const f32x4 (&acc)[2][2][4][2], const Unit& u, int wr, int wc, int fr, int fq) const {
        const int rl0 = wr * 64 + fr, col0 = u.pn * BM + wc * 32 + 8 * fq;
#pragma unroll
        EPI_LOOP_ROWS { const int rl = rl0 + ai * HALF + m * 16;
            if (rl < u.x1) { const int ts = row_ts[u.x0 + rl]; const float w = row_w[u.x0 + rl];
                bf16_t* dst = contrib + ((size_t)(ts & 1) * 16384 + (size_t)(ts >> 1)) * 2048 + col0;
#pragma unroll
                for (int bj = 0; bj < 2; ++bj) *(u32x4*)(dst + bj * HALF) = pack8(acc[ai][bj][m][0] * w, acc[ai][bj][m][1] * w); } }
    }
};
struct EpiGate : EpiBase {
    const bf16_t* x2b; const bf16_t* pp; const float* r2; bf16_t* x3b; float* ssq;
    __device__ __forceinline__ void operator()(const f32x4 (&acc)[2][2][4][2], const Unit& u, int wr, int wc, int fr, int fq) const {
        const int row0 = u.pm * BM + wr * 64 + fr, col0 = u.pn * BM + wc * 32 + 8 * fq;
#pragma unroll
        EPI_LOOP_ROWS { const int row = row0 + ai * HALF + m * 16; const float r = r2[row]; float s = 0.f;
#pragma unroll
            for (int bj = 0; bj < 2; ++bj) { const size_t off = (size_t)row * 2048 + col0 + bj * HALF;
                const u32x4 xv = *(const u32x4*)(x2b + off), pv = *(const u32x4*)(pp + off);
                f32x4 v0, v1;
                v0[0] = bf_lo(xv.x) + fast_sigmoid(acc[ai][bj][m][0][0] * r) * bf_lo(pv.x); v0[1] = bf_hi(xv.x) + fast_sigmoid(acc[ai][bj][m][0][1] * r) * bf_hi(pv.x);
                v0[2] = bf_lo(xv.y) + fast_sigmoid(acc[ai][bj][m][0][2] * r) * bf_lo(pv.y); v0[3] = bf_hi(xv.y) + fast_sigmoid(acc[ai][bj][m][0][3] * r) * bf_hi(pv.y);
                v1[0] = bf_lo(xv.z) + fast_sigmoid(acc[ai][bj][m][1][0] * r) * bf_lo(pv.z); v1[1] = bf_hi(xv.z) + fast_sigmoid(acc[ai][bj][m][1][1] * r) * bf_hi(pv.z);
                v1[2] = bf_lo(xv.w) + fast_sigmoid(acc[ai][bj][m][1][2] * r) * bf_lo(pv.w); v1[3] = bf_hi(xv.w) + fast_sigmoid(acc[ai][bj][m][1][3] * r) * bf_hi(pv.w);
                s += (v0[0] * v0[0] + v0[1] * v0[1]) + (v0[2] * v0[2] + v0[3] * v0[3]) + (v1[0] * v1[0] + v1[1] * v1[1]) + (v1[2] * v1[2] + v1[3] * v1[3]);
                *(u32x4*)(x3b + off) = pack8(v0, v1); }
            s += __shfl_xor(s, 16); s += __shfl_xor(s, 32);
            if (fq == 0) ssq[(size_t)row * 32 + u.pn * 4 + wc] = s; }
    }
};
#undef EPI_LOOP_ROWS
}
#include <hip/hip_bf16.h>
#include <cmath>
namespace attn_body {
using bf16=__hip_bfloat16;
using bf16x8=__attribute__((ext_vector_type(8)))short;
using s16x4=__attribute__((ext_vector_type(4)))short;
using f32x16=__attribute__((ext_vector_type(16)))float;
using u32x4=__attribute__((ext_vector_type(4)))unsigned;
constexpr int BATCH=4,NHEAD=16,SEQ=4096,D=64,DM=NHEAD*D,OPITCH=2048;
constexpr int LUTN=132;
constexpr int NW=8,QBLK=32,QB=QBLK*NW,KVBLK=64,NQB=SEQ/QB;
constexpr int ATTN_PITCH=DM, ATTN_UNIT_ROWS=QB;
__device__ __forceinline__ int crow(int r,int hi){return (r&3)+8*(r>>2)+4*hi;}
#define SBAR() __builtin_amdgcn_sched_barrier(0)
__device__ __forceinline__ void cmask(f32x16&p0,f32x16&p1,int jb,int qrel,int hi){
  const float NEG=-INFINITY; int kb=64*jb+4*hi;
  #pragma unroll
  for(int r=0;r<16;++r){int kv=kb+(r&3)+8*(r>>2); if(kv>qrel)p0[r]=NEG; if(kv+32>qrel)p1[r]=NEG;}
}

__device__ __forceinline__ void cbias(f32x16&p0,f32x16&p1,int jb,int qrel,int hi,const __attribute__((address_space(3))) float*lut){
  const int base=qrel-64*jb-4*hi;
  #pragma unroll
  for(int g=0;g<4;++g){
    #pragma unroll
    for(int q=0;q<4;++q){const int r=4*g+q; int d0=base-((r&3)+8*(r>>2)); int d1=d0-32; d0=d0<0?0:(d0>128?128:d0); d1=d1<0?0:(d1>128?128:d1); p0[r]+=lut[d0]; p1[r]+=lut[d1];}
    __builtin_amdgcn_sched_barrier(0);
  }
}
constexpr int NSLOT=3, SLOTB=8192;
constexpr int LDS_K=0, LDS_V=NSLOT*SLOTB, LDS_WS=2*NSLOT*SLOTB, LDS_OST=LDS_WS+NW*64*4, LDS_LUT=LDS_OST+NW*4096, LDS_BYTES=LDS_LUT+1024;
constexpr float C2=0.125f*1.4426950408889634f;
__device__ __forceinline__ void glds16(const void*gsrc,unsigned lds_dst){unsigned keep;
  asm volatile("s_mov_b32 %0, m0\n\ts_mov_b32 m0, %2\n\ts_nop 0\n\tglobal_load_lds_dwordx4 %1, off\n\ts_mov_b32 m0, %0":"=&s"(keep):"v"(gsrc),"s"(lds_dst):"memory");}
__device__ __forceinline__ float max3f(float a,float b,float c){float r;asm("v_max3_f32 %0, %1, %2, %3":"=v"(r):"v"(a),"v"(b),"v"(c));return r;}
__device__ __forceinline__ float max2f(float a,float b){float r;asm("v_max_f32_e32 %0, %1, %2":"=v"(r):"v"(a),"v"(b));return r;}
__device__ __forceinline__ float fadd_s(float a,float b){float r;asm("v_add_f32_e32 %0, %1, %2":"=v"(r):"v"(a),"v"(b));return r;}
__device__ __forceinline__ float fsub_s(float a,float b){float r;asm("v_sub_f32_e32 %0, %1, %2":"=v"(r):"v"(a),"v"(b));return r;}
typedef float f32x2_t __attribute__((ext_vector_type(2))); typedef __bf16 bf16x2_t __attribute__((ext_vector_type(2)));
__device__ __forceinline__ unsigned cvtpk_s(float lo,float hi){f32x2_t v={lo,hi};bf16x2_t b=__builtin_convertvector(v,bf16x2_t);return __builtin_bit_cast(unsigned,b);}
#define WAIT_BAR(N) asm volatile("s_waitcnt vmcnt(" #N ") lgkmcnt(0)\n\ts_barrier":::"memory")

__device__ __forceinline__ void qkt(f32x16&p0,f32x16&p1,const char*Kslot,const bf16x8*qr,const f32x16&negm,int r32,int hi){
  const char*kb=Kslot+hi*1024+r32*16;
  #pragma unroll
  for(int d0=0;d0<4;++d0){
    const bf16x8 b0=*reinterpret_cast<const bf16x8*>(kb+d0*2048);
    const bf16x8 b1=*reinterpret_cast<const bf16x8*>(kb+d0*2048+512);
    if(d0==0){p0=__builtin_amdgcn_mfma_f32_32x32x16_bf16(b0,qr[0],negm,0,0,0);p1=__builtin_amdgcn_mfma_f32_32x32x16_bf16(b1,qr[0],negm,0,0,0);}
    else{p0=__builtin_amdgcn_mfma_f32_32x32x16_bf16(b0,qr[d0],p0,0,0,0);p1=__builtin_amdgcn_mfma_f32_32x32x16_bf16(b1,qr[d0],p1,0,0,0);}}
}
typedef __attribute__((address_space(3))) const char* lds_cptr;
typedef short v4i16_t __attribute__((ext_vector_type(4)));
__device__ __forceinline__ void kload8(bf16x8*kf,lds_cptr kp){
  kf[0]=*(const __attribute__((address_space(3))) bf16x8*)(kp);      kf[1]=*(const __attribute__((address_space(3))) bf16x8*)(kp+512);
  kf[2]=*(const __attribute__((address_space(3))) bf16x8*)(kp+2048); kf[3]=*(const __attribute__((address_space(3))) bf16x8*)(kp+2560);
  kf[4]=*(const __attribute__((address_space(3))) bf16x8*)(kp+4096); kf[5]=*(const __attribute__((address_space(3))) bf16x8*)(kp+4608);
  kf[6]=*(const __attribute__((address_space(3))) bf16x8*)(kp+6144); kf[7]=*(const __attribute__((address_space(3))) bf16x8*)(kp+6656);
}
__device__ __forceinline__ void kload2(bf16x8*kf,lds_cptr kp,int j){ kf[2*j]=*(const __attribute__((address_space(3))) bf16x8*)(kp+j*2048); kf[2*j+1]=*(const __attribute__((address_space(3))) bf16x8*)(kp+j*2048+512); }
__device__ __forceinline__ s16x4 vtr(lds_cptr p){ return __builtin_bit_cast(s16x4,__builtin_amdgcn_ds_read_tr16_b64_v4i16((__attribute__((address_space(3))) v4i16_t*)p)); }
__device__ __forceinline__ float rowmax(const f32x16&p0,const f32x16&p1){
  float a=max3f(p0[0],p0[1],p1[0]),b=max3f(p0[2],p0[3],p1[1]);a=max3f(a,p1[2],p1[3]);
  #pragma unroll
  for(int r=4;r<16;r+=4){a=max3f(a,p0[r],p0[r+1]);b=max3f(b,p0[r+2],p0[r+3]);a=max3f(a,p1[r],p1[r+1]);b=max3f(b,p1[r+2],p1[r+3]);}
  const float m=max2f(a,b);
  auto rr=__builtin_amdgcn_permlane32_swap(__float_as_uint(m),__float_as_uint(m),false,false);
  return max2f(__uint_as_float(rr[0]),__uint_as_float(rr[1]));
}
__device__ __forceinline__ void pv(f32x16*o,int vb,bf16x8 pa0,bf16x8 pa1,bf16x8 pa2,bf16x8 pa3){
  #pragma unroll
  for(int d0=0;d0<2;++d0){s16x4 lo[4],hi[4];
    #pragma unroll
    for(int ks=0;ks<4;++ks){
      asm volatile("ds_read_b64_tr_b16 %0,%1 offset:%c2":"=&v"(lo[ks]):"v"(vb),"i"(d0*4096+ks*1024):"memory");
      asm volatile("ds_read_b64_tr_b16 %0,%1 offset:%c2":"=&v"(hi[ks]):"v"(vb),"i"(d0*4096+ks*1024+512):"memory");}
    asm volatile("s_waitcnt lgkmcnt(0)":::"memory");SBAR();
    #define PK(k) (bf16x8){lo[k][0],lo[k][1],lo[k][2],lo[k][3],hi[k][0],hi[k][1],hi[k][2],hi[k][3]}
    o[d0]=__builtin_amdgcn_mfma_f32_32x32x16_bf16(pa0,PK(0),o[d0],0,0,0);
    o[d0]=__builtin_amdgcn_mfma_f32_32x32x16_bf16(pa1,PK(1),o[d0],0,0,0);
    o[d0]=__builtin_amdgcn_mfma_f32_32x32x16_bf16(pa2,PK(2),o[d0],0,0,0);
    o[d0]=__builtin_amdgcn_mfma_f32_32x32x16_bf16(pa3,PK(3),o[d0],0,0,0);
    #undef PK
  }
}

#ifndef ATTN_STORE16
#define ATTN_STORE16(p,v) (*(u32x4*)(p)=(v))
#endif
template<int THRL> __device__ __forceinline__ void attn_unit(int b,int h,int hv,int ocol,int qb,const bf16*Q,const bf16*__restrict__ K,const bf16*__restrict__ V,bf16*O,const float*lutg,char*shm){
  const int tid=threadIdx.x,lane=tid&63,r32=lane&31,hi=lane>>5; const int wid=__builtin_amdgcn_readfirstlane(tid>>6);
  const long rowbase=(long)b*SEQ; const int q0=qb*QB;
  const bf16*Qw=Q+(rowbase+q0+wid*QBLK)*DM+h*D;
  const bf16*Kh=K+rowbase*DM+h*D,*Vh=V+rowbase*DM+hv*D;
  const unsigned lds0=(unsigned)(uintptr_t)shm;
  float*wsf=(float*)(shm+LDS_WS)+wid*64;
  const bf16*ksrc=Kh+(long)lane*DM+wid*8;
  const bf16*vsrc=Vh+(long)(16*(wid&3)+(lane>>2))*DM+(wid>>2)*32+(lane&3)*8;
  const unsigned kdst=lds0+LDS_K+wid*1024, vdst=lds0+LDS_V+wid*1024;
  #define DMA_K(t,slot) glds16(ksrc+(long)(t)*KVBLK*DM,(unsigned)__builtin_amdgcn_readfirstlane(kdst+(slot)))
  #define DMA_V(t,slot) glds16(vsrc+(long)(t)*KVBLK*DM,(unsigned)__builtin_amdgcn_readfirstlane(vdst+(slot)))
  const int vb0=(int)(lds0+LDS_V)+((lane>>4)&1)*32+(lane&3)*8+(4*hi+((lane&15)>>2))*64;
  const char*Kbase=shm+LDS_K; bf16x8 kf[8];
  const lds_cptr shm3=(lds_cptr)shm; const lds_cptr kp0=shm3+LDS_K+hi*1024+r32*16; const lds_cptr vp0=shm3+LDS_V+((lane>>4)&1)*32+(lane&3)*8+(4*hi+((lane&15)>>2))*64;
  const int NT=(q0+QB)/KVBLK;
  const __attribute__((address_space(3))) float*lut=(const __attribute__((address_space(3))) float*)(shm3+LDS_LUT);
  if(tid<LUTN)((__attribute__((address_space(3))) float*)(shm3+LDS_LUT))[tid]=lutg[tid];
  DMA_K(0,0);DMA_V(0,0);DMA_K(1,SLOTB);
  bf16x8 qr[4];
  #pragma unroll
  for(int d0=0;d0<4;++d0)qr[d0]=*reinterpret_cast<const bf16x8*>(&Qw[(long)r32*DM+d0*16+hi*8]);
  float mhat=0.f,l_reg=0.f;f32x16 o[2];o[0]=f32x16{};o[1]=f32x16{};f32x16 negm=f32x16{};asm volatile("":"+v"(negm));
  const int qrel=wid*QBLK+r32;
  #define CMASK(P0,P1,t) do{int jb_=(t)-(NT-4); if(jb_>=-2){ if(wid*QBLK-64*jb_-63<128)cbias(P0,P1,jb_,qrel,hi,lut); if(jb_>=0)cmask(P0,P1,jb_,qrel,hi);} }while(0)
  bool resc=false;
  #define START(P0,P1) do{ const float rm=rowmax(P0,P1); resc=false; \
    { const float dl=rm; mhat=fadd_s(mhat,dl); \
      _Pragma("unroll") for(int r=0;r<16;++r){P0[r]=fsub_s(P0[r],dl);P1[r]=fsub_s(P1[r],dl);} \
      _Pragma("unroll") for(int r=0;r<16;++r)negm[r]=-mhat; asm volatile("":"+v"(negm)); } \
    _Pragma("unroll") for(int r=0;r<16;++r)P0[r]=__builtin_amdgcn_exp2f(P0[r]); }while(0)
  #define RESC() do{ if(resc){ asm volatile("s_waitcnt lgkmcnt(0)":::"memory"); \
      _Pragma("unroll") for(int d_=0;d_<2;++d_) _Pragma("unroll") for(int r=0;r<16;++r)o[d_][r]*=wsf[crow(r,hi)]; } }while(0)
  f32x16 pA0,pA1,pB0,pB1;
  int sl_prev=0,sl_cur=0,sl_next=SLOTB;
  #define ROT() do{sl_prev=sl_cur;sl_cur=sl_next;sl_next=(sl_next==(NSLOT-1)*SLOTB)?0:sl_next+SLOTB;}while(0)
  DMA_K(2,2*SLOTB);
  WAIT_BAR(3);
  qkt(pA0,pA1,Kbase,qr,negm,r32,hi);asm volatile("s_nop 15\n\ts_nop 7":"+v"(pA0),"+v"(pA1));CMASK(pA0,pA1,0);
  START(pA0,pA1);
  _Pragma("unroll") for(int r=0;r<16;++r)pA1[r]=__builtin_amdgcn_exp2f(pA1[r]);
  WAIT_BAR(0);
  DMA_K(3,0);DMA_V(1,SLOTB);
  ROT();
  kload8(kf,kp0+sl_cur);
  WAIT_BAR(2);
  s16x4 vlo[8],vhi[8]; u32x4 pw0,pw1,pw2,pw3;
  #define PKW(P,B) cvtpk_s(P[B],P[B+1])
  #define PAF(k) __builtin_bit_cast(bf16x8,pw##k)
  #define VFR(i) (bf16x8){vlo[i][0],vlo[i][1],vlo[i][2],vlo[i][3],vhi[i][0],vhi[i][1],vhi[i][2],vhi[i][3]}
  #define PIN(x) asm volatile("":"+v"(x))
  #define MX3(a,b,c) __builtin_fmaxf(__builtin_fmaxf((a),(b)),(c))
  #define GAPA(MF,A0,A1,A2,A3,W0,W1,PW) do{ MF; sacc+=A0; sacc+=A1; sacc+=A2; sacc+=A3; PIN(sacc); W0; W1; PIN(PW); SBAR(); }while(0)
  #define EX(v) __builtin_amdgcn_exp2f(v)
  #define GAPB(MF,X,B) do{ MF; X[B]=EX(X[B]); X[B+1]=EX(X[B+1]); X[B+2]=EX(X[B+2]); X[B+3]=EX(X[B+3]); PIN(X); SBAR(); }while(0)
  #define VRD(i) do{ vlo[i]=vtr(vp_+(((i)>>2)*4096+((i)&3)*1024)); vhi[i]=vtr(vp_+(((i)>>2)*4096+((i)&3)*1024+512)); }while(0)
  #define KRD(G,j) do{ if(G){ kload2(kf,kp0+sl_next,j); SBAR(); } }while(0)
  #define STEP(C0,C1,P0,P1,t,GK,GV,GL) do{ SBAR(); \
    const lds_cptr vp_=vp0+sl_prev; \
    VRD(0); SBAR(); float sacc=(P0[0]+P0[1]); \
    GAPA(C0=__builtin_amdgcn_mfma_f32_32x32x16_bf16(kf[0],qr[0],negm,0,0,0), P0[2],P0[3],P0[4],P0[5],     pw0[0]=PKW(P0,0), pw0[1]=PKW(P0,2), pw0); \
    VRD(4); SBAR(); GAPA(C1=__builtin_amdgcn_mfma_f32_32x32x16_bf16(kf[1],qr[0],negm,0,0,0), P0[6],P0[7],P0[8],P0[9],     pw0[2]=PKW(P0,4), pw0[3]=PKW(P0,6), pw0); \
    VRD(1); SBAR(); GAPA(C0=__builtin_amdgcn_mfma_f32_32x32x16_bf16(kf[2],qr[1],C0,0,0,0),   P0[10],P0[11],P0[12],P0[13], pw1[0]=PKW(P0,8), pw1[1]=PKW(P0,10), pw1); \
    VRD(5); SBAR(); GAPA(C1=__builtin_amdgcn_mfma_f32_32x32x16_bf16(kf[3],qr[1],C1,0,0,0),   P0[14],P0[15],P1[0],P1[1],   pw1[2]=PKW(P0,12),pw1[3]=PKW(P0,14), pw1); \
    VRD(2); SBAR(); GAPA(C0=__builtin_amdgcn_mfma_f32_32x32x16_bf16(kf[4],qr[2],C0,0,0,0),   P1[2],P1[3],P1[4],P1[5],     pw2[0]=PKW(P1,0), pw2[1]=PKW(P1,2), pw2); \
    VRD(6); SBAR(); GAPA(C1=__builtin_amdgcn_mfma_f32_32x32x16_bf16(kf[5],qr[2],C1,0,0,0),   P1[6],P1[7],P1[8],P1[9],     pw2[2]=PKW(P1,4), pw2[3]=PKW(P1,6), pw2); \
    VRD(3); SBAR(); GAPA(C0=__builtin_amdgcn_mfma_f32_32x32x16_bf16(kf[6],qr[3],C0,0,0,0),   P1[10],P1[11],P1[12],P1[13], pw3[0]=PKW(P1,8), pw3[1]=PKW(P1,10), pw3); \
    VRD(7); SBAR(); GAPA(C1=__builtin_amdgcn_mfma_f32_32x32x16_bf16(kf[7],qr[3],C1,0,0,0),   P1[14],P1[15],0.f,0.f,       pw3[2]=PKW(P1,12),pw3[3]=PKW(P1,14), pw3); \
    l_reg+=sacc; \
    if(GK){DMA_K((t)+3,sl_cur);} if(GV){DMA_V((t)+1,sl_next);} \
    CMASK(C0,C1,t); \
    { float a=MX3(C0[0],C0[1],C1[0]),b=MX3(C0[2],C0[3],C1[1]); a=MX3(a,C1[2],C1[3]); \
      _Pragma("unroll") for(int r=4;r<16;r+=4){a=MX3(a,C0[r],C0[r+1]);b=MX3(b,C0[r+2],C0[r+3]);a=MX3(a,C1[r],C1[r+1]);b=MX3(b,C1[r+2],C1[r+3]);} \
      float rm=__builtin_fmaxf(a,b); { auto rr=__builtin_amdgcn_permlane32_swap(__float_as_uint(rm),__float_as_uint(rm),false,false); rm=__builtin_fmaxf(__uint_as_float(rr[0]),__uint_as_float(rr[1])); } \
      resc=false; \
      if(__builtin_expect(__any(rm>(float)THRL),0)){ const float dl=__builtin_fmaxf(rm,0.f); mhat+=dl; \
        _Pragma("unroll") for(int r=0;r<16;++r){C0[r]-=dl;C1[r]-=dl;} \
        _Pragma("unroll") for(int r=0;r<16;++r)negm[r]=-mhat; asm volatile("":"+v"(negm)); \
        const float f=__builtin_amdgcn_exp2f(-dl); l_reg*=f; if(hi==0)wsf[r32]=f; resc=true; } } \
    SBAR(); \
    GAPB(o[0]=__builtin_amdgcn_mfma_f32_32x32x16_bf16(PAF(0),VFR(0),o[0],0,0,0), C0,0); \
    GAPB(o[1]=__builtin_amdgcn_mfma_f32_32x32x16_bf16(PAF(0),VFR(4),o[1],0,0,0), C0,4); \
    KRD(GL,0); GAPB(o[0]=__builtin_amdgcn_mfma_f32_32x32x16_bf16(PAF(1),VFR(1),o[0],0,0,0), C0,8); \
    KRD(GL,1); GAPB(o[1]=__builtin_amdgcn_mfma_f32_32x32x16_bf16(PAF(1),VFR(5),o[1],0,0,0), C0,12); \
    KRD(GL,2); GAPB(o[0]=__builtin_amdgcn_mfma_f32_32x32x16_bf16(PAF(2),VFR(2),o[0],0,0,0), C1,0); \
    KRD(GL,3); GAPB(o[1]=__builtin_amdgcn_mfma_f32_32x32x16_bf16(PAF(2),VFR(6),o[1],0,0,0), C1,4); \
    GAPB(o[0]=__builtin_amdgcn_mfma_f32_32x32x16_bf16(PAF(3),VFR(3),o[0],0,0,0), C1,8); \
    GAPB(o[1]=__builtin_amdgcn_mfma_f32_32x32x16_bf16(PAF(3),VFR(7),o[1],0,0,0), C1,12); \
    }while(0)
  int t=1;
  #undef CMASK
  #define CMASK(P0,P1,t) do{}while(0)
  for(;t+7<NT;t+=2){
    STEP(pB0,pB1,pA0,pA1,t,true,true,true);     WAIT_BAR(2); RESC(); ROT();
    STEP(pA0,pA1,pB0,pB1,t+1,true,true,true);   WAIT_BAR(2); RESC(); ROT();
  }
  #undef CMASK
  #define CMASK(P0,P1,t) do{int jb_=(t)-(NT-4); if(jb_>=-2){ if(wid*QBLK-64*jb_-63<128)cbias(P0,P1,jb_,qrel,hi,lut); if(jb_>=0)cmask(P0,P1,jb_,qrel,hi);} }while(0)
  #define ENDW(tt) do{ if((tt)+3<NT){WAIT_BAR(2);} else if((tt)+2<NT){WAIT_BAR(1);} else {WAIT_BAR(0);} }while(0)
  for(;t+1<NT;t+=2){
    STEP(pB0,pB1,pA0,pA1,t,(t+3<NT),(t+1<NT),(t+1<NT));       ENDW(t);   RESC(); ROT();
    STEP(pA0,pA1,pB0,pB1,t+1,(t+4<NT),(t+2<NT),(t+2<NT));     ENDW(t+1); RESC(); ROT();
  }
  STEP(pB0,pB1,pA0,pA1,NT-1,false,false,false); RESC();
  { float sacc=pB0[0]+pB0[1]; _Pragma("unroll") for(int r=2;r<16;++r)sacc+=pB0[r]; _Pragma("unroll") for(int r=0;r<16;++r)sacc+=pB1[r]; l_reg+=sacc;
    pw0=(u32x4){PKW(pB0,0),PKW(pB0,2),PKW(pB0,4),PKW(pB0,6)};pw1=(u32x4){PKW(pB0,8),PKW(pB0,10),PKW(pB0,12),PKW(pB0,14)};pw2=(u32x4){PKW(pB1,0),PKW(pB1,2),PKW(pB1,4),PKW(pB1,6)};pw3=(u32x4){PKW(pB1,8),PKW(pB1,10),PKW(pB1,12),PKW(pB1,14)};
    SBAR(); pv(o,vb0+sl_cur,PAF(0),PAF(1),PAF(2),PAF(3)); }
  #undef PKW
  #undef PAF
  #undef VFR
  #undef PIN
  #undef MX3
  #undef GAPA
  #undef GAPB
  #undef EX
  #undef VRD
  #undef KRD
  #undef STEP
  #undef ENDW
  {auto rr=__builtin_amdgcn_permlane32_swap(__float_as_uint(l_reg),__float_as_uint(l_reg),false,false);l_reg=__uint_as_float(rr[0])+__uint_as_float(rr[1]);}
  if(hi==0)wsf[32+r32]=l_reg;asm volatile("s_waitcnt lgkmcnt(0)":::"memory");
  float rli[16];
  #pragma unroll
  for(int r=0;r<16;++r)rli[r]=__builtin_amdgcn_rcpf(wsf[32+crow(r,hi)]);
  bf16*Ow=O+(rowbase+q0+wid*QBLK)*OPITCH+ocol;
  { bf16*stg=(bf16*)(shm+LDS_OST)+wid*2048;
    #pragma unroll
    for(int r=0;r<16;++r){const int orow=crow(r,hi);
      #pragma unroll
      for(int d0=0;d0<2;++d0)stg[orow*64+d0*32+r32]=__float2bfloat16(o[d0][r]*rli[r]);}
    asm volatile("s_waitcnt lgkmcnt(0)":::"memory");
    #pragma unroll
    for(int i=0;i<4;++i){const int row=i*8+(lane>>3),ch=lane&7; const u32x4 v=*(const u32x4*)(stg+row*64+ch*8); ATTN_STORE16(Ow+(long)row*OPITCH+ch*8,v);} }
  asm volatile("s_waitcnt lgkmcnt(0)\n\ts_barrier":::"memory");
  #undef DMA_K
  #undef DMA_V
  #undef CMASK
  #undef START
  #undef RESC
  #undef ROT
}
constexpr int ATTN_LDS_BYTES=LDS_BYTES;
struct AttnTensors { const bf16* Q; const bf16* K; const bf16* V; bf16* O; const float* lutg; };
struct AttnUnit { int combo; int qb; };
struct StaticOrder {
  int vcu;
  __device__ __forceinline__ explicit StaticOrder(int grid,int block):vcu((grid%8==0)?(block%8)*(grid/8)+block/8:block){}
  __device__ __forceinline__ bool next(int i,AttnUnit&u)const{ if(i>=8||vcu>=256)return false; const int par=vcu&1,s=i>>1; u.combo=vcu>>1; u.qb=(i&1)?15-(2*s+par):(2*s+par); return true; }
  __device__ __forceinline__ void a_ready(const AttnUnit&)const{}
  __device__ __forceinline__ void done(const AttnUnit&)const{}
};
template<class Sched,int THRL=8> __device__ __forceinline__ void attn_phase(char*lds,const AttnTensors&T,const Sched&S){
  AttnUnit u;
  int lim_=8; asm volatile("":"+s"(lim_));
  for(int i=0;i<lim_&&S.next(i,u);++i){ const int j=u.combo&1,c=(u.combo>>1)&1,h=(u.combo>>2)&7,b=u.combo>>5;
    attn_unit<THRL>(b,2*h+c,2*h+j,c*1024+h*128+j*64,u.qb,T.Q,T.K,T.V,T.O,T.lutg+h*LUTN,lds); }
}
#undef SBAR
#undef WAIT_BAR
}
constexpr int NWAVES = 8;
#ifndef MK_ONE_LAUNCH
#define MK_ONE_LAUNCH 0
#endif
constexpr int NPH = 12;

constexpr int M = 16384, D = 2048, SEQ = 4096, NB = 4;
constexpr int NE = 32, DE = 512, ECAP = 16384, PLE = 256;
constexpr float EPS = 1e-6f;

constexpr size_t MiB = 1u << 20;
constexpr size_t WS_CTL = 0, CTL_ZERO_BYTES = 1 * MiB;
constexpr size_t WS_R0 = 1 * MiB, WS_R2 = WS_R0 + 65536, WS_LUT = WS_R2 + 65536, WS_SSC = WS_LUT + 8192;
constexpr size_t WS_SSQ1 = 2 * MiB, WS_SSQ3 = 4 * MiB, WS_RTS = 6 * MiB, WS_RW = 8 * MiB, WS_RR = 10 * MiB;
constexpr size_t WS_WIN = 12 * MiB, WS_WGLU = 28 * MiB, WS_WO = 30 * MiB, WS_WPG = 38 * MiB, WS_WPP = 46 * MiB, WS_WR = 47 * MiB, WS_W1T = 48 * MiB, WS_TVT = 56 * MiB, WS_W13 = 68 * MiB, WS_W2 = 196 * MiB;
constexpr size_t WS_A = 260 * MiB;
constexpr size_t WS_B = 324 * MiB;
constexpr size_t WS_B2 = WS_B + 64 * MiB;
constexpr size_t WS_PP = 452 * MiB, WS_PBF = 516 * MiB, WS_END = 524 * MiB;
constexpr int CW_TMO = 0, CW_CODE = 1, CW_CNT = 64;
constexpr int CW_BAR = 4096;

constexpr int RING_OFF = 0, RING_BYTES = 131072;
constexpr int LDSCTL_OFF = RING_BYTES, MISC_OFF = LDSCTL_OFF + 320;
constexpr int XTRA_OFF = RING_BYTES + 1024;
constexpr int LDS_BYTES = 147456;
static_assert(XTRA_OFF + 8192 <= LDS_BYTES, "LDS map");

#define GAS __attribute__((address_space(1)))
#define LAS __attribute__((address_space(3)))
typedef unsigned short bf16;
typedef unsigned v4u __attribute__((ext_vector_type(4)));
typedef unsigned v2u __attribute__((ext_vector_type(2)));
typedef float f32x4 __attribute__((ext_vector_type(4)));
typedef short bf16x8 __attribute__((ext_vector_type(8)));
typedef float f32x16 __attribute__((ext_vector_type(16)));
typedef GAS unsigned gu32;
#define RLX_AGENT __ATOMIC_RELAXED, __HIP_MEMORY_SCOPE_AGENT
#define LDS_WAIT() asm volatile("s_waitcnt lgkmcnt(0)" ::: "memory")
#define VM_WAIT() asm volatile("s_waitcnt vmcnt(0)" ::: "memory")
__device__ __forceinline__ unsigned f2bf(float f) { unsigned u = __builtin_bit_cast(unsigned, f); return (u + 0x7fffu + ((u >> 16) & 1u)) >> 16; }
__device__ __forceinline__ unsigned pk2(float lo, float hi) { return f2bf(lo) | (f2bf(hi) << 16); }
__device__ __forceinline__ float bflo(unsigned w) { return __builtin_bit_cast(float, w << 16); }
__device__ __forceinline__ float bfhi(unsigned w) { return __builtin_bit_cast(float, w & 0xffff0000u); }

#define XB_TMO      128
#define XB_XCNT(j)  (256  + 64 * (j))
#define XB_XSUB(j)  (1280 + 64 * (j))
#define XB_XGEN(j)  (2304 + 64 * (j))
#define XB_TOP      3328
#define XB_TOPGEN   3392
#define XCD_BAR_WORDS 3456
#define XB_SPIN_CAP (1u << 18)

__device__ __forceinline__ unsigned xb_ld(unsigned* p)              { return __hip_atomic_load(p, __ATOMIC_RELAXED, __HIP_MEMORY_SCOPE_AGENT); }
__device__ __forceinline__ unsigned xb_add(unsigned* p, unsigned v) { return __hip_atomic_fetch_add(p, v, __ATOMIC_RELAXED, __HIP_MEMORY_SCOPE_AGENT); }
__device__ __forceinline__ unsigned xb_xcc_id() { return (unsigned)__builtin_amdgcn_s_getreg((3 << 11) | 20) & 0xFu; }
#define XB_SPIN(cond, bar) do { unsigned _sp = 0; while (cond) { __builtin_amdgcn_s_sleep(1); \
    if ((++_sp & 255u) == 0u) { if (xb_ld(&(bar)[XB_TMO])) break; if (_sp > XB_SPIN_CAP) { atomicAdd(&(bar)[XB_TMO], 1u); break; } } } } while (0)

struct XcdBarrier {
    unsigned* bar; unsigned x;
    volatile LAS unsigned* st;
};
__device__ __forceinline__ XcdBarrier xcd_barrier_post(unsigned* bar, volatile LAS unsigned* st) {
    XcdBarrier b; b.bar = bar; b.x = xb_xcc_id(); b.st = st;
    if (threadIdx.x == 0) (void)xb_add(&bar[XB_XCNT(b.x)], 1u);
    return b;
}
__device__ __forceinline__ void xcd_barrier_complete(unsigned* bar, unsigned x, unsigned& nloc, unsigned& nx) {
    const unsigned G = gridDim.x * gridDim.y * gridDim.z;
    unsigned sum, cnt, mine, sp = 0u;
    for (;;) {
        sum = 0u; cnt = 0u; mine = 0u;
#pragma unroll
        for (unsigned j = 0; j < 16; ++j) { const unsigned c = xb_ld(&bar[XB_XCNT(j)]); sum += c; cnt += (c > 0u) ? 1u : 0u; mine = (j == x) ? c : mine; }
        if (sum == G) break;
        __builtin_amdgcn_s_sleep(1);
        if ((++sp & 255u) == 0u) { if (xb_ld(&bar[XB_TMO])) break; if (sp > XB_SPIN_CAP) { atomicAdd(&bar[XB_TMO], 1u); break; } }
    }
    nloc = mine > 0u ? mine : 1u; nx = cnt > 0u ? cnt : 1u;
}
__device__ __forceinline__ void xcd_barrier(const XcdBarrier& b) {
    asm volatile("s_waitcnt vmcnt(0)" ::: "memory");
    __syncthreads();
    if (threadIdx.x == 0) {
        unsigned* bar = b.bar;
        __builtin_amdgcn_s_waitcnt(0);
        unsigned nloc = b.st[0], nx = b.st[1];
        if (nloc == 0u) { xcd_barrier_complete(bar, b.x, nloc, nx); b.st[0] = nloc; b.st[1] = nx; }
        const unsigned old = xb_add(&bar[XB_XSUB(b.x)], 1u);
        const unsigned gen = old / nloc;
        if (old + 1u == (gen + 1u) * nloc) {
            __builtin_amdgcn_fence(__ATOMIC_RELEASE, "agent");
            asm volatile("s_waitcnt vmcnt(0)" ::: "memory");
            const unsigned og = xb_add(&bar[XB_TOP], 1u);
            const unsigned tg = og / nx;
            if (og + 1u == (tg + 1u) * nx) xb_add(&bar[XB_TOPGEN], 1u);
            else XB_SPIN(xb_ld(&bar[XB_TOPGEN]) == tg, bar);
            __builtin_amdgcn_fence(__ATOMIC_ACQUIRE, "agent");
            xb_add(&bar[XB_XGEN(b.x)], 1u);
            asm volatile("s_waitcnt vmcnt(0)" ::: "memory");
        } else {
            XB_SPIN(xb_ld(&bar[XB_XGEN(b.x)]) == gen, bar);
            __builtin_amdgcn_fence(__ATOMIC_ACQUIRE, "agent");
            asm volatile("s_waitcnt vmcnt(0)" ::: "memory");
        }
    }
    __syncthreads();
}

struct Frame {
    LAS unsigned char* lds;
    volatile LAS unsigned* MISC;
    gu32* ctl;
    int tid, lane, wave;
    int vcu, G;
};
__device__ __forceinline__ float wave_sum(float v) {
#pragma unroll
    for (int o = 1; o < 64; o <<= 1) v += __shfl_xor(v, o);
    return v;
}
__device__ __forceinline__ void p0_tr(const float* W, int N, const float* gk, bf16* WT, int ldk, int k0, int n0, int drow0, int dk0, LAS float* scr, int lane) {
#pragma unroll 8
    for (int i = 0; i < 32; ++i) { const int kk = 2 * i + (lane >> 5); float v = W[(size_t)(k0 + kk) * N + n0 + (lane & 31)]; if (gk) v *= gk[k0 + kk]; scr[kk * 33 + (lane & 31)] = v; }
    LDS_WAIT(); asm volatile("" ::: "memory");
    const int c = lane & 7;
#pragma unroll
    for (int j = 0; j < 4; ++j) { const int n = (lane >> 3) + 8 * j; const LAS float* s = scr + (8 * c) * 33 + n;
        v4u o; o.x = pk2(s[0 * 33], s[1 * 33]); o.y = pk2(s[2 * 33], s[3 * 33]); o.z = pk2(s[4 * 33], s[5 * 33]); o.w = pk2(s[6 * 33], s[7 * 33]);
        *(GAS v4u*)(WT + (size_t)(drow0 + n) * ldk + dk0 + 8 * c) = o; }
    LDS_WAIT(); asm volatile("" ::: "memory");
}

struct Ptrs {
    const float *x, *p, *rel_bias, *g_mix, *w_in, *lq1, *lk1, *lq2, *lk2, *subg, *s_lre, *s_lim, *s_ldt, *s_bre, *s_bim, *s_cre, *s_cim, *s_d, *w_glu, *b_glu, *g_ssm, *w_o, *g_ffn,
                *w_rg, *b_rg, *w_re, *b_re, *w1, *w3, *w2, *g_ple, *w_pg, *w_pp, *g_final;
    float* out; unsigned char* ws;
};

__device__ __forceinline__ void p0_ssm_group(const Frame& F, const Ptrs& P, int g) {
    LAS float* L = (LAS float*)(F.lds + RING_OFF);
    LAS float* pw = L;
    LAS float* bbr = L + 2304;
    LAS float* bbi = bbr + 1024;
    LAS float* cre = bbi + 1024;
    LAS float* cim = cre + 1024;
    LAS float* Kt = cim + 1024;
    LAS float* dd = Kt + 4096;
    const int tid = F.tid;
    if (tid < 64) {
        const int p = tid;
        const float lre = P.s_lre[g * 64 + p], lim = P.s_lim[g * 64 + p], dt = expf(P.s_ldt[g]);
        const float mag = expf(lre * dt), ar = mag * cosf(lim * dt), ai = mag * sinf(lim * dt);
        const float den = lre * lre + lim * lim, nr = ar - 1.f, ni = ai;
        const float cr = (nr * lre + ni * lim) / den, ci = (ni * lre - nr * lim) / den;
        float gr = 1.f, gi = 0.f;
        for (int n = 0; n <= 16; ++n) { pw[(n * 64 + p) * 2] = gr; pw[(n * 64 + p) * 2 + 1] = gi; const float t = gr * ar - gi * ai; gi = gr * ai + gi * ar; gr = t; }
        float a16r = pw[(16 * 64 + p) * 2], a16i = pw[(16 * 64 + p) * 2 + 1], qr = a16r, qi = a16i;
        for (int s = 0; s < 5; ++s) { const float t = qr * qr - qi * qi; qi = 2.f * qr * qi; qr = t; }
        float* sc = (float*)(P.ws + WS_SSC) + (g * 64 + p) * 4; sc[0] = a16r; sc[1] = a16i; sc[2] = qr; sc[3] = qi;
        for (int h = 0; h < 16; ++h) { const float br = P.s_bre[(g * 64 + p) * 16 + h], bi = P.s_bim[(g * 64 + p) * 16 + h]; bbr[p * 16 + h] = cr * br - ci * bi; bbi[p * 16 + h] = cr * bi + ci * br; }
    }
    for (int i = tid; i < 1024; i += NWAVES * 64) { cre[i] = P.s_cre[g * 1024 + i]; cim[i] = P.s_cim[g * 1024 + i]; }
    if (tid < 16) dd[tid] = P.s_d[g * 16 + tid];
    __syncthreads();
    for (int idx = tid; idx < 4096; idx += NWAVES * 64) {
        const int tau = idx >> 8, h = (idx >> 4) & 15, h2 = idx & 15; float s = 0.f;
        for (int p = 0; p < 64; ++p) { const float gr = pw[(tau * 64 + p) * 2], gi = pw[(tau * 64 + p) * 2 + 1], br = bbr[p * 16 + h2], bi = bbi[p * 16 + h2];
            s += cre[h * 64 + p] * (gr * br - gi * bi) - cim[h * 64 + p] * (gr * bi + gi * br); }
        Kt[idx] = s;
    }
    __syncthreads();
    bf16* TV = (bf16*)(P.ws + WS_TVT) + (size_t)g * 256 * 384;
    for (int it = tid; it < 256 * 48; it += NWAVES * 64) {
        const int n = it / 48, k0 = (it % 48) * 8, i = n >> 4, h = n & 15; float v[8];
#pragma unroll
        for (int q = 0; q < 8; ++q) { const int k = k0 + q;
            if (k < 256) { const int j = k >> 4, h2 = k & 15; float t = (j <= i) ? Kt[((i - j) * 16 + h) * 16 + h2] : 0.f; if (j == i && h2 == h) t += dd[h]; v[q] = t; }
            else { const int p = (k - 256) & 63, part = (k - 256) >> 6; const float gr = pw[((i + 1) * 64 + p) * 2], gi = pw[((i + 1) * 64 + p) * 2 + 1], c1 = cre[h * 64 + p], c2 = cim[h * 64 + p];
                   v[q] = part == 0 ? (c1 * gr - c2 * gi) : (-c1 * gi - c2 * gr); } }
        v4u o; o.x = pk2(v[0], v[1]); o.y = pk2(v[2], v[3]); o.z = pk2(v[4], v[5]); o.w = pk2(v[6], v[7]);
        *(GAS v4u*)(TV + (size_t)n * 384 + k0) = o;
    }
    bf16* W1 = (bf16*)(P.ws + WS_W1T) + (size_t)g * 256 * 256;
    for (int it = tid; it < 256 * 32; it += NWAVES * 64) {
        const int n = it >> 5, k0 = (it & 31) * 8; float v[8];
#pragma unroll
        for (int q = 0; q < 8; ++q) { const int k = k0 + q, j = k >> 4, h2 = k & 15;
            if (n < 128) { const int p = n & 63; const float gr = pw[((15 - j) * 64 + p) * 2], gi = pw[((15 - j) * 64 + p) * 2 + 1], br = bbr[p * 16 + h2], bi = bbi[p * 16 + h2];
                           v[q] = n < 64 ? (gr * br - gi * bi) : (gr * bi + gi * br); }
            else v[q] = 0.f; }
        v4u o; o.x = pk2(v[0], v[1]); o.y = pk2(v[2], v[3]); o.z = pk2(v[4], v[5]); o.w = pk2(v[6], v[7]);
        *(GAS v4u*)(W1 + (size_t)n * 256 + k0) = o;
    }
    __syncthreads();
}

__device__ __forceinline__ void p0_prologue(const Frame& F, const Ptrs& P) {
    unsigned char* ws = P.ws;
    for (int g = F.vcu; g < 64; g += F.G) p0_ssm_group(F, P, g);
    LAS float* scr = (LAS float*)(F.lds + RING_OFF + F.wave * 16384);
    const int gw = F.vcu * NWAVES + F.wave, NGW = F.G * NWAVES, lane = F.lane;
    constexpr int I_IN = 32 * 128, I_GLU = 16 * 32, I_O = 32 * 64, I_13 = 2 * NE * 32 * 16, I_2 = NE * 8 * 64, I_PG = 32 * 64, I_PP = 4 * 64;
    constexpr int NITEMS = I_IN + I_GLU + I_O + I_13 + I_2 + I_PG + I_PP;
    for (int it = gw; it < NITEMS; it += NGW) {
        int r = it;
        if (r < I_IN) { const int kb = r / 128, nb = r % 128; p0_tr(P.w_in, 4096, P.g_mix, (bf16*)(ws + WS_WIN), 2048, 64 * kb, 32 * nb, 32 * nb, 64 * kb, scr, lane); continue; } r -= I_IN;
        if (r < I_GLU) { const int kb = r / 32, nb = r % 32; p0_tr(P.w_glu, 1024, nullptr, (bf16*)(ws + WS_WGLU), 1024, 64 * kb, 32 * nb, 32 * nb, 64 * kb, scr, lane); continue; } r -= I_GLU;
        if (r < I_O) { const int kb = r / 64, nb = r % 64;
            p0_tr(P.w_o, 2048, nullptr, (bf16*)(ws + WS_WO), 2048, 64 * kb, 32 * nb, 32 * nb, (64 * kb + 1024) & 2047, scr, lane); continue; } r -= I_O;
        if (r < I_13) { const int e = r / 1024, q = r % 1024, mat = q >> 9, kb = (q & 511) / 16, nb = q & 15, n0 = 32 * nb;
            p0_tr((mat ? P.w3 : P.w1) + (size_t)e * 2048 * 512, 512, P.g_ffn, (bf16*)(ws + WS_W13) + (size_t)e * 1024 * 2048, 2048, 64 * kb, n0, (n0 >> 7) * 256 + mat * 128 + (n0 & 127), 64 * kb, scr, lane); continue; } r -= I_13;
        if (r < I_2) { const int e = r / 512, q = r % 512, kb = q / 64, nb = q % 64;
            p0_tr(P.w2 + (size_t)e * 512 * 2048, 2048, nullptr, (bf16*)(ws + WS_W2) + (size_t)e * 2048 * 512, 512, 64 * kb, 32 * nb, 32 * nb, 64 * kb, scr, lane); continue; } r -= I_2;
        if (r < I_PG) { const int kb = r / 64, nb = r % 64; p0_tr(P.w_pg, 2048, P.g_ple, (bf16*)(ws + WS_WPG), 2048, 64 * kb, 32 * nb, 32 * nb, 64 * kb, scr, lane); continue; } r -= I_PG;
        { const int kb = r / 64, nb = r % 64; p0_tr(P.w_pp, 2048, nullptr, (bf16*)(ws + WS_WPP), 256, 64 * kb, 32 * nb, 32 * nb, 64 * kb, scr, lane); }
    }
    for (int m = gw; m < M; m += NGW) {
        const GAS f32x4* xr = (const GAS f32x4*)(P.x + (size_t)m * D) + lane; f32x4 v[8]; float s = 0.f;
#pragma unroll
        for (int j = 0; j < 8; ++j) { v[j] = xr[64 * j]; s += (v[j].x * v[j].x + v[j].y * v[j].y) + (v[j].z * v[j].z + v[j].w * v[j].w); }
        s = wave_sum(s);
        if (lane == 0) ((float*)(ws + WS_R0))[m] = 1.0f / sqrtf(s * (1.f / D) + EPS);
        GAS v2u* o8 = (GAS v2u*)((bf16*)(ws + WS_A) + (size_t)m * D) + lane;
#pragma unroll
        for (int j = 0; j < 8; ++j) { v2u o; o.x = pk2(v[j].x, v[j].y); o.y = pk2(v[j].z, v[j].w); o8[64 * j] = o; }
    }
    { const int gt = (F.vcu * NWAVES + F.wave) * 64 + lane, NT = F.G * NWAVES * 64;
      for (int i = gt; i < M * PLE / 4; i += NT) { const f32x4 v = ((const GAS f32x4*)P.p)[i]; v2u o; o.x = pk2(v.x, v.y); o.y = pk2(v.z, v.w); ((GAS v2u*)(ws + WS_PBF))[i] = o; }
      for (int i = gt; i < 64 * 2048; i += NT) { const int j = i >> 11, k = i & 2047; float v = 0.f;
          if (j < 4) v = P.w_rg[k * 4 + j] * P.g_ffn[k]; else if (j < 36) v = P.w_re[k * 32 + (j - 4)] * P.g_ffn[k];
          ((bf16*)(ws + WS_WR))[i] = (bf16)f2bf(v); }
      for (int i = gt; i < 8 * 132; i += NT) { const int h = i / 132, n = i % 132; int bucket;
          if (n < 16) bucket = n; else { const int lg = 16 + (int)(logf((float)n / 16.f) / 2.0794415416798357f * 16.f); bucket = lg < 31 ? lg : 31; }
          ((float*)(ws + WS_LUT))[i] = (P.rel_bias[bucket * 8 + h] - P.rel_bias[31 * 8 + h]) * 1.4426950408889634f; }
    }
}

__device__ __forceinline__ void ssm_scan(const Frame& F, const Ptrs& P, int g, bf16* item) {
    const LAS float* E = (const LAS float*)(F.lds + RING_OFF);
    LAS float* S = (LAS float*)(F.lds + XTRA_OFF);
    const int p = F.lane, w = F.wave, c0 = 32 * w;
    const f32x4 sc = *(const f32x4*)((const float*)(P.ws + WS_SSC) + (g * 64 + p) * 4);
    float xr = 0.f, xi = 0.f;
#pragma unroll 8
    for (int c = c0; c < c0 + 32; ++c) { const float er = E[c * 128 + p], ei = E[c * 128 + 64 + p]; const float t = sc.x * xr - sc.y * xi + er; xi = sc.x * xi + sc.y * xr + ei; xr = t; }
    S[(w * 64 + p) * 2] = xr; S[(w * 64 + p) * 2 + 1] = xi;
    __syncthreads();
    xr = 0.f; xi = 0.f;
    for (int w2 = 0; w2 < w; ++w2) { const float t = sc.z * xr - sc.w * xi + S[(w2 * 64 + p) * 2]; xi = sc.z * xi + sc.w * xr + S[(w2 * 64 + p) * 2 + 1]; xr = t; }
#pragma unroll 8
    for (int c = c0; c < c0 + 32; ++c) {
        bf16* row = item + (size_t)c * 384 + 256; row[p] = (bf16)f2bf(xr); row[64 + p] = (bf16)f2bf(xi);
        const float er = E[c * 128 + p], ei = E[c * 128 + 64 + p]; const float t = sc.x * xr - sc.y * xi + er; xi = sc.x * xi + sc.y * xr + ei; xr = t; }
    VM_WAIT(); __syncthreads();
}
struct OneUnit { pg8::Unit u; __device__ __forceinline__ bool next(int i, pg8::Unit& o) const { if (i > 0) return false; o = u; return true; } };

__device__ __forceinline__ void p4_finalize(const Frame& F, const Ptrs& P) {
    const int lane = F.lane, gw = F.vcu * NWAVES + F.wave, NGW = F.G * NWAVES;
    const float lam = __expf(wave_sum(P.lq1[lane] * P.lk1[lane])) - __expf(wave_sum(P.lq2[lane] * P.lk2[lane])) + 0.2f;
    const bf16* O12 = (const bf16*)(P.ws + WS_A); bf16* scat = (bf16*)(P.ws + WS_B);
    float sg[16], gs[16];
#pragma unroll
    for (int i = 0; i < 16; ++i) { sg[i] = P.subg[(16 * lane & 127) + i] * 0.8f; gs[i] = P.g_ssm[16 * lane + i]; }
    for (int m = gw; m < M; m += NGW) {
        const v4u a0 = *(const GAS v4u*)(O12 + (size_t)m * 2048 + 16 * lane), a1 = *(const GAS v4u*)(O12 + (size_t)m * 2048 + 16 * lane + 8);
        const v4u b0 = *(const GAS v4u*)(O12 + (size_t)m * 2048 + 1024 + 16 * lane), b1 = *(const GAS v4u*)(O12 + (size_t)m * 2048 + 1024 + 16 * lane + 8);
        const v4u s0 = *(const GAS v4u*)(scat + (size_t)m * 2048 + 16 * lane), s1 = *(const GAS v4u*)(scat + (size_t)m * 2048 + 16 * lane + 8);
        float v[16], s[16]; float qa = 0.f, qs = 0.f;
#pragma unroll
        for (int i = 0; i < 4; ++i) {
            v[2 * i] = bflo(a0[i]) - lam * bflo(b0[i]); v[2 * i + 1] = bfhi(a0[i]) - lam * bfhi(b0[i]); v[8 + 2 * i] = bflo(a1[i]) - lam * bflo(b1[i]); v[8 + 2 * i + 1] = bfhi(a1[i]) - lam * bfhi(b1[i]);
            s[2 * i] = bflo(s0[i]); s[2 * i + 1] = bfhi(s0[i]); s[8 + 2 * i] = bflo(s1[i]); s[8 + 2 * i + 1] = bfhi(s1[i]); }
#pragma unroll
        for (int i = 0; i < 16; ++i) { qa += v[i] * v[i]; qs += s[i] * s[i]; }
        qa += __shfl_xor(qa, 1); qa += __shfl_xor(qa, 2); qa += __shfl_xor(qa, 4);
        qs = wave_sum(qs);
        const float ra = 1.0f / sqrtf(qa * (1.f / 128.f) + 1e-5f), rs = 1.0f / sqrtf(qs * (1.f / 1024.f) + EPS);
        v4u o0, o1, p0, p1;
#pragma unroll
        for (int i = 0; i < 4; ++i) { o0[i] = pk2(v[2 * i] * ra * sg[2 * i], v[2 * i + 1] * ra * sg[2 * i + 1]); o1[i] = pk2(v[8 + 2 * i] * ra * sg[8 + 2 * i], v[8 + 2 * i + 1] * ra * sg[8 + 2 * i + 1]);
                                      p0[i] = pk2(s[2 * i] * rs * gs[2 * i], s[2 * i + 1] * rs * gs[2 * i + 1]); p1[i] = pk2(s[8 + 2 * i] * rs * gs[8 + 2 * i], s[8 + 2 * i + 1] * rs * gs[8 + 2 * i + 1]); }
        *(GAS v4u*)(scat + (size_t)m * 2048 + 1024 + 16 * lane) = o0; *(GAS v4u*)(scat + (size_t)m * 2048 + 1024 + 16 * lane + 8) = o1;
        *(GAS v4u*)(scat + (size_t)m * 2048 + 16 * lane) = p0; *(GAS v4u*)(scat + (size_t)m * 2048 + 16 * lane + 8) = p1;
    }
}

__device__ __forceinline__ void p6_router(const Frame& F, const Ptrs& P) {
    const int lane = F.lane, w = F.wave, th = w & 1, kq = w >> 1, r32 = lane & 31, hi = lane >> 5;
    const bf16* x1b = (const bf16*)(P.ws + WS_A); const bf16* WrT = (const bf16*)(P.ws + WS_WR);
    LAS float* red = (LAS float*)(F.lds + RING_OFF);
    LAS int* lcnt = (LAS int*)(F.lds + XTRA_OFF);
    int* cnt = (int*)(F.ctl + CW_CNT);
    int* row_ts = (int*)(P.ws + WS_RTS); float* row_w = (float*)(P.ws + WS_RW); float* row_r = (float*)(P.ws + WS_RR);
    const float* ssq1 = (const float*)(P.ws + WS_SSQ1);
    for (int blk = F.vcu; blk < M / 64; blk += F.G) {
        const int T0 = blk * 64;
        if (F.tid < 64) lcnt[F.tid] = 0;
        f32x16 acc0 = {}, acc1 = {};
        const bf16* ap = x1b + (size_t)(T0 + 32 * th + r32) * 2048 + kq * 512 + 8 * hi;
        const bf16* bp0 = WrT + (size_t)r32 * 2048 + kq * 512 + 8 * hi; const bf16* bp1 = bp0 + 32 * 2048;
#pragma unroll 4
        for (int ks = 0; ks < 32; ++ks) {
            const bf16x8 a = *(const GAS bf16x8*)(ap + ks * 16), b0 = *(const GAS bf16x8*)(bp0 + ks * 16), b1 = *(const GAS bf16x8*)(bp1 + ks * 16);
            acc0 = __builtin_amdgcn_mfma_f32_32x32x16_bf16(a, b0, acc0, 0, 0, 0); acc1 = __builtin_amdgcn_mfma_f32_32x32x16_bf16(a, b1, acc1, 0, 0, 0);
        }
#pragma unroll
        for (int r = 0; r < 16; ++r) { const int tk = 32 * th + (r & 3) + 8 * (r >> 2) + 4 * hi; red[(kq * 64 + tk) * 64 + r32] = acc0[r]; red[(kq * 64 + tk) * 64 + 32 + r32] = acc1[r]; }
        __syncthreads();
        int e0 = 0, e1 = 0, lp0 = 0, lp1 = 0; float w0 = 0.f, w1 = 0.f, r1 = 0.f;
        if (F.tid < 64) {
            const int tok = T0 + F.tid; float ss = 0.f;
            for (int i = 0; i < 32; ++i) ss += ssq1[(size_t)tok * 32 + i];
            r1 = 1.0f / sqrtf(ss * (1.f / D) + EPS);
            float lg[4];
#pragma unroll
            for (int j = 0; j < 4; ++j) lg[j] = (red[(0 * 64 + F.tid) * 64 + j] + red[(1 * 64 + F.tid) * 64 + j] + red[(2 * 64 + F.tid) * 64 + j] + red[(3 * 64 + F.tid) * 64 + j]) * r1 + P.b_rg[j];
            int gs = 0; float lm = lg[0];
            if (lg[1] > lm) { lm = lg[1]; gs = 1; } if (lg[2] > lm) { lm = lg[2]; gs = 2; } if (lg[3] > lm) { lm = lg[3]; gs = 3; }
            const float gate_g = 1.0f / (__expf(lg[0] - lm) + __expf(lg[1] - lm) + __expf(lg[2] - lm) + __expf(lg[3] - lm));
            float m0 = -3.0e38f, m1 = -3.0e38f; int i0 = 0, i1 = 0;
            for (int j = 0; j < 8; ++j) { const int c = 4 + gs * 8 + j;
                const float le = (red[(0 * 64 + F.tid) * 64 + c] + red[(1 * 64 + F.tid) * 64 + c] + red[(2 * 64 + F.tid) * 64 + c] + red[(3 * 64 + F.tid) * 64 + c]) * r1 + P.b_re[gs * 8 + j];
                if (le > m0) { m1 = m0; i1 = i0; m0 = le; i0 = j; } else if (le > m1) { m1 = le; i1 = j; } }
            const float p1 = __expf(m1 - m0);
            w0 = gate_g / (1.f + p1); w1 = gate_g * p1 / (1.f + p1); e0 = gs * 8 + i0; e1 = gs * 8 + i1;
            lp0 = atomicAdd((int*)&lcnt[e0], 1); lp1 = atomicAdd((int*)&lcnt[e1], 1);
        }
        __syncthreads();
        if (F.tid < 32) { const int n = lcnt[F.tid]; lcnt[32 + F.tid] = n ? atomicAdd(&cnt[F.tid], n) : 0; }
        __syncthreads();
        if (F.tid < 64) { const int tok = T0 + F.tid;
            const int i0 = e0 * ECAP + lcnt[32 + e0] + lp0, i1 = e1 * ECAP + lcnt[32 + e1] + lp1;
            row_ts[i0] = tok * 2; row_w[i0] = w0; row_r[i0] = r1; row_ts[i1] = tok * 2 + 1; row_w[i1] = w1; row_r[i1] = r1; }
        __syncthreads();
    }
}

template <int NTN, bool UP>
struct MoeOrder {
    const LAS int* pre;
    const char* A; const char* B; const int* row_ts; const int* cnt; int G, c;
    __device__ __forceinline__ bool next(int i, pg8::Unit& u) const {
        const int L = i * G + c, TT = pre[32]; if (L >= TT * NTN) return false;
        const int ti = L / NTN, nt = L % NTN; int e = 0;
        for (int q = 1; q < 32; ++q) e += (ti >= pre[q]) ? 1 : 0;
        const int mt = ti - pre[e];
        u.pm = ti; u.pn = nt; u.x0 = e * ECAP + mt * 256;
        if (UP) { u.A = A; u.B = B + ((size_t)e * 1024 + (size_t)nt * 256) * 2048 * 2; u.rows = row_ts + u.x0; u.x1 = ti; }
        else { u.A = A + (size_t)ti * 256 * 512 * 2; u.B = B + ((size_t)e * 2048 + (size_t)nt * 256) * 512 * 2; u.rows = nullptr; const int left = cnt[e] - mt * 256; u.x1 = left < 256 ? left : 256; }
        if (UP) { const int left = cnt[e] - mt * 256; u.pn = nt; u.pm = left < 256 ? left : 256; }
        return true;
    }
    __device__ __forceinline__ int arow(const pg8::Unit& u, int r) const { return r < u.pm ? (u.rows[r] >> 1) : 0; }
};
__device__ __forceinline__ void moe_prefix(const Frame& F) {
    LAS int* pre = (LAS int*)(F.lds + XTRA_OFF + 1024);
    __syncthreads();
    if (F.tid == 0) { int s = 0; for (int e = 0; e < 32; ++e) { pre[e] = s; s += ((int)__hip_atomic_load(F.ctl + CW_CNT + e, RLX_AGENT) + 255) >> 8; } pre[32] = s; }
    __syncthreads();
}

__device__ __forceinline__ void p9_combine(const Frame& F, const Ptrs& P) {
    const int lane = F.lane, gw = F.vcu * NWAVES + F.wave, NGW = F.G * NWAVES;
    const bf16* x1b = (const bf16*)(P.ws + WS_A); const bf16* c0 = (const bf16*)P.out; const bf16* c1 = c0 + (size_t)M * 2048; bf16* x2b = (bf16*)(P.ws + WS_B);
    for (int m = gw; m < M; m += NGW) { float q = 0.f; v4u o[4];
#pragma unroll
        for (int j = 0; j < 4; ++j) { const size_t off = (size_t)m * 2048 + (size_t)(j * 64 + lane) * 8;
            const v4u a = *(const GAS v4u*)(x1b + off), b = *(const GAS v4u*)(c0 + off), c = *(const GAS v4u*)(c1 + off);
#pragma unroll
            for (int i = 0; i < 4; ++i) { const float lo = bflo(a[i]) + bflo(b[i]) + bflo(c[i]), hi = bfhi(a[i]) + bfhi(b[i]) + bfhi(c[i]); q += lo * lo + hi * hi; o[j][i] = pk2(lo, hi); } }
        q = wave_sum(q);
        if (lane == 0) ((float*)(P.ws + WS_R2))[m] = 1.0f / sqrtf(q * (1.f / D) + EPS);
#pragma unroll
        for (int j = 0; j < 4; ++j) *(GAS v4u*)(x2b + (size_t)m * 2048 + (size_t)(j * 64 + lane) * 8) = o[j];
    }
}
__device__ __forceinline__ void p11_final(const Frame& F, const Ptrs& P) {
    const int lane = F.lane, gw = F.vcu * NWAVES + F.wave, NGW = F.G * NWAVES;
    const bf16* x3b = (const bf16*)(P.ws + WS_B2); const float* ssq3 = (const float*)(P.ws + WS_SSQ3);
    for (int m = gw; m < M; m += NGW) {
        const float r3 = 1.0f / sqrtf(wave_sum(lane < 32 ? ssq3[(size_t)m * 32 + lane] : 0.f) * (1.f / D) + EPS);
#pragma unroll
        for (int j = 0; j < 4; ++j) { const size_t col = (size_t)(j * 64 + lane) * 8; const v4u a = *(const GAS v4u*)(x3b + (size_t)m * 2048 + col);
            const f32x4 g0 = *(const GAS f32x4*)(P.g_final + col), g1 = *(const GAS f32x4*)(P.g_final + col + 4);
            f32x4 o0, o1; o0.x = bflo(a.x) * r3 * g0.x; o0.y = bfhi(a.x) * r3 * g0.y; o0.z = bflo(a.y) * r3 * g0.z; o0.w = bfhi(a.y) * r3 * g0.w;
            o1.x = bflo(a.z) * r3 * g1.x; o1.y = bfhi(a.z) * r3 * g1.y; o1.z = bflo(a.w) * r3 * g1.z; o1.w = bfhi(a.w) * r3 * g1.w;
            *(GAS f32x4*)(P.out + (size_t)m * 2048 + col) = o0; *(GAS f32x4*)(P.out + (size_t)m * 2048 + col + 4) = o1; }
    }
}

struct Args { const float* in[34]; float* out; unsigned char* ws; int ph_lo, ph_hi, li, pad; };
__global__ void __launch_bounds__(NWAVES * 64, 2) mk_fwd(Args args) {
    extern __shared__ __attribute__((aligned(16))) unsigned char lds[];
    Frame F;
    F.lds = (LAS unsigned char*)lds;
    F.MISC = (volatile LAS unsigned*)(F.lds + MISC_OFF);
    F.tid = threadIdx.x; F.lane = F.tid & 63; F.wave = __builtin_amdgcn_readfirstlane(F.tid >> 6);
    F.G = gridDim.x; { const int bx = blockIdx.x; F.vcu = (F.G % 8 == 0) ? (bx % 8) * (F.G / 8) + bx / 8 : bx; }
    Ptrs P;
    P.x = args.in[0]; P.p = args.in[1]; P.rel_bias = args.in[2]; P.g_mix = args.in[3]; P.w_in = args.in[4]; P.lq1 = args.in[5]; P.lk1 = args.in[6]; P.lq2 = args.in[7]; P.lk2 = args.in[8]; P.subg = args.in[9];
    P.s_lre = args.in[10]; P.s_lim = args.in[11]; P.s_ldt = args.in[12]; P.s_bre = args.in[13]; P.s_bim = args.in[14]; P.s_cre = args.in[15]; P.s_cim = args.in[16]; P.s_d = args.in[17];
    P.w_glu = args.in[18]; P.b_glu = args.in[19]; P.g_ssm = args.in[20]; P.w_o = args.in[21]; P.g_ffn = args.in[22]; P.w_rg = args.in[23]; P.b_rg = args.in[24]; P.w_re = args.in[25]; P.b_re = args.in[26];
    P.w1 = args.in[27]; P.w3 = args.in[28]; P.w2 = args.in[29]; P.g_ple = args.in[30]; P.w_pg = args.in[31]; P.w_pp = args.in[32]; P.g_final = args.in[33];
    P.out = args.out; P.ws = args.ws;
    unsigned char* ws = args.ws;
    F.ctl = (gu32*)(ws + WS_CTL);
    for (int u = F.tid; u < (LDS_BYTES - LDSCTL_OFF) / 4; u += NWAVES * 64) ((LAS unsigned*)(F.lds + LDSCTL_OFF))[u] = 0u;
    __syncthreads();
    XcdBarrier bar; bar.bar = (unsigned*)(F.ctl + CW_BAR); bar.x = 0; bar.st = nullptr;
    if (MK_ONE_LAUNCH) bar = xcd_barrier_post((unsigned*)(F.ctl + CW_BAR), F.MISC + 8);
#define GRID_BAR() do { if (MK_ONE_LAUNCH) xcd_barrier(bar); } while (0)
    const int lo = args.ph_lo, hi = args.ph_hi;
#ifndef ONLY_PH
#define ONLY_PH -1
#endif
#define IN(k) ((ONLY_PH == -1 || ONLY_PH == (k)) && lo <= (k) && (k) < hi)
#define BOTH(k) (IN(k) && IN((k) + 1))
    bf16* Qb = (bf16*)P.out; bf16* Kb = Qb + (size_t)M * 1024; bf16* Vb = Kb + (size_t)M * 1024; bf16* s1b = Vb + (size_t)M * 1024;
    bf16* Ue = (bf16*)(ws + WS_B);

    if (IN(0)) { p0_prologue(F, P); if (BOTH(0)) GRID_BAR(); }

    if (IN(1)) {
        pg8::DenseOrder S; S.init(ws + WS_A, ws + WS_WIN, 2048, 2048, M, 4096, F.G, (int)blockIdx.x);
        pg8::EpiZ E; E.Q = Qb; E.Ue = Ue; E.r0 = (const float*)(ws + WS_R0); E.c2 = attn_body::C2;
        pg8::gemm_phase<pg8::EpiZ, pg8::DenseOrder, true, false>(F.lds + RING_OFF, 2048, 2048, 2048, S, E);
        if (BOTH(1)) GRID_BAR();
    }
    if (IN(2)) {
#ifndef SKIP_SSM
        for (int item = F.vcu; item < 256; item += F.G) {
            const int g = item >> 2, b = item & 3;
            bf16* itA = Ue + (size_t)item * 256 * 384;
            OneUnit S1; S1.u.A = (const char*)itA; S1.u.B = (const char*)((bf16*)(ws + WS_W1T) + (size_t)g * 256 * 256); S1.u.rows = nullptr; S1.u.pm = 0; S1.u.pn = 0; S1.u.x0 = g; S1.u.x1 = b;
            pg8::EpiE E1;
            pg8::gemm_phase<pg8::EpiE, OneUnit, false, false>(F.lds + RING_OFF, 256, 384, 256, S1, E1);
            __syncthreads();
            ssm_scan(F, P, g, itA);
            OneUnit S2; S2.u = S1.u; S2.u.B = (const char*)((bf16*)(ws + WS_TVT) + (size_t)g * 256 * 384);
            pg8::EpiY E2; E2.s1 = s1b;
            pg8::gemm_phase<pg8::EpiY, OneUnit, false, false>(F.lds + RING_OFF, 384, 384, 384, S2, E2);
            __syncthreads();
        }
#endif
#ifndef SKIP_ATTN
        const attn_body::AttnTensors AT{(const attn_body::bf16*)Qb, (const attn_body::bf16*)Kb, (const attn_body::bf16*)Vb, (attn_body::bf16*)(ws + WS_A), (const float*)(ws + WS_LUT)};
        const attn_body::StaticOrder S((int)F.G, (int)blockIdx.x);
        attn_body::attn_phase<attn_body::StaticOrder>((char*)lds + RING_OFF, AT, S);
#endif
        if (BOTH(2)) GRID_BAR();
    }
    if (IN(3)) {
        pg8::DenseOrder S; S.init(s1b, ws + WS_WGLU, 1024, 1024, M, 1024, F.G, (int)blockIdx.x);
        pg8::EpiGlu E; E.s1 = s1b; E.bias = P.b_glu; E.scat = (bf16*)(ws + WS_B);
        pg8::gemm_phase<pg8::EpiGlu, pg8::DenseOrder, true, false>(F.lds + RING_OFF, 1024, 1024, 1024, S, E);
        if (BOTH(3)) GRID_BAR();
    }
    if (IN(4)) { p4_finalize(F, P); if (BOTH(4)) GRID_BAR(); }
    if (IN(5)) {
        pg8::DenseOrder S; S.init(ws + WS_B, ws + WS_WO, 2048, 2048, M, 2048, F.G, (int)blockIdx.x);
        pg8::EpiRes1 E; E.x = P.x; E.x1b = (bf16*)(ws + WS_A); E.ssq = (float*)(ws + WS_SSQ1);
        pg8::gemm_phase<pg8::EpiRes1, pg8::DenseOrder, true, false>(F.lds + RING_OFF, 2048, 2048, 2048, S, E);
        if (BOTH(5)) GRID_BAR();
    }
    if (IN(6)) {
#ifndef SKIP_ROUTER
        p6_router(F, P);
#endif
#ifndef SKIP_PP
        pg8::DenseOrder S; S.init(ws + WS_PBF, ws + WS_WPP, 256, 256, M, 2048, F.G, (int)blockIdx.x);
        pg8::EpiPP E; E.pp = (bf16*)(ws + WS_PP);
        pg8::gemm_phase<pg8::EpiPP, pg8::DenseOrder, true, false>(F.lds + RING_OFF, 256, 256, 256, S, E);
#endif
        if (BOTH(6)) GRID_BAR();
    }
    if (IN(7)) {
        moe_prefix(F);
        MoeOrder<4, true> S; S.pre = (const LAS int*)(F.lds + XTRA_OFF + 1024); S.A = (const char*)(ws + WS_A); S.B = (const char*)(ws + WS_W13); S.row_ts = (const int*)(ws + WS_RTS); S.cnt = (const int*)(F.ctl + CW_CNT); S.G = F.G; S.c = F.vcu;
        pg8::EpiUp E; E.row_r = (const float*)(ws + WS_RR); E.hmid = (bf16*)(ws + WS_B2);
        pg8::gemm_phase<pg8::EpiUp, MoeOrder<4, true>, true, true>(F.lds + RING_OFF, 2048, 2048, 2048, S, E);
        if (BOTH(7)) GRID_BAR();
    }
    if (IN(8)) {
        moe_prefix(F);
        MoeOrder<8, false> S; S.pre = (const LAS int*)(F.lds + XTRA_OFF + 1024); S.A = (const char*)(ws + WS_B2); S.B = (const char*)(ws + WS_W2); S.row_ts = (const int*)(ws + WS_RTS); S.cnt = (const int*)(F.ctl + CW_CNT); S.G = F.G; S.c = F.vcu;
        pg8::EpiDown E; E.row_ts = (const int*)(ws + WS_RTS); E.row_w = (const float*)(ws + WS_RW); E.contrib = (bf16*)P.out;
        pg8::gemm_phase<pg8::EpiDown, MoeOrder<8, false>, true, false>(F.lds + RING_OFF, 512, 512, 512, S, E);
        if (BOTH(8)) GRID_BAR();
    }
    if (IN(9)) { p9_combine(F, P); if (BOTH(9)) GRID_BAR(); }
    if (IN(10)) {
        pg8::DenseOrder S; S.init(ws + WS_B, ws + WS_WPG, 2048, 2048, M, 2048, F.G, (int)blockIdx.x);
        pg8::EpiGate E; E.x2b = (const bf16*)(ws + WS_B); E.pp = (const bf16*)(ws + WS_PP); E.r2 = (const float*)(ws + WS_R2); E.x3b = (bf16*)(ws + WS_B2); E.ssq = (float*)(ws + WS_SSQ3);
        pg8::gemm_phase<pg8::EpiGate, pg8::DenseOrder, true, false>(F.lds + RING_OFF, 2048, 2048, 2048, S, E);
        if (BOTH(10)) GRID_BAR();
    }
    if (IN(11)) { p11_final(F, P); }
#undef IN
#undef BOTH
}

extern "C" void kernel_launch(void* const* d_in, const int* in_sizes, int n_in, void* d_out, int out_size, void* d_ws, size_t ws_size, hipStream_t stream) {
    static int grid = 0;
    if (grid == 0) {
        if (n_in != 34 || out_size != M * D || ws_size < WS_END) { fprintf(stderr, "kernel_launch: unexpected shapes (n_in %d, out %d, ws %zu); nothing launched\n", n_in, out_size, ws_size); grid = -1; return; }
        int dev = 0, cus = 0, per_cu = 0;
        if (hipGetDevice(&dev) != hipSuccess || hipDeviceGetAttribute(&cus, hipDeviceAttributeMultiprocessorCount, dev) != hipSuccess) { grid = -1; return; }
        if (hipFuncSetAttribute((const void*)mk_fwd, hipFuncAttributeMaxDynamicSharedMemorySize, LDS_BYTES) != hipSuccess) { fprintf(stderr, "kernel_launch: hipFuncSetAttribute failed\n"); grid = -1; return; }
        if (hipOccupancyMaxActiveBlocksPerMultiprocessor(&per_cu, (const void*)mk_fwd, NWAVES * 64, LDS_BYTES) != hipSuccess || per_cu < 1) { fprintf(stderr, "kernel_launch: occupancy query reports %d\n", per_cu); per_cu = 1; }
        (void)hipGetLastError();
        grid = cus;
    }
    if (grid < 0) return;
    if (hipMemsetAsync((char*)d_ws + WS_CTL, 0, CTL_ZERO_BYTES, stream) != hipSuccess) return;
    Args a{};
    for (int i = 0; i < 34; ++i) a.in[i] = (const float*)d_in[i];
    a.out = (float*)d_out; a.ws = (unsigned char*)d_ws; a.pad = 0;
    if (MK_ONE_LAUNCH) { a.ph_lo = 0; a.ph_hi = NPH; a.li = 0; hipLaunchKernelGGL(mk_fwd, dim3(grid), dim3(NWAVES * 64), LDS_BYTES, stream, a); }
    else for (int li = 0; li < NPH; ++li) { a.ph_lo = li; a.ph_hi = li + 1; a.li = li; hipLaunchKernelGGL(mk_fwd, dim3(grid), dim3(NWAVES * 64), LDS_BYTES, stream, a); }
}
```

```cpp
#include <hip/hip_runtime.h>
#include <hip/hip_bf16.h>
#include <cstdio>
#include <cstdint>
#include <cmath>
namespace pg8 {
#define PG8_LAS __attribute__((address_space(3)))
typedef unsigned short bf16_t;
typedef short bf16x8 __attribute__((ext_vector_type(8)));
typedef float f32x4 __attribute__((ext_vector_type(4)));
typedef float f32x2 __attribute__((ext_vector_type(2)));
typedef unsigned u32x4 __attribute__((ext_vector_type(4)));
typedef int v4i __attribute__((ext_vector_type(4)));
typedef int v8i __attribute__((ext_vector_type(8)));
constexpr int BM = 256, BK = 64, HALF = 128, HTB = HALF * BK * 2  , STAGE_BYTES = 8 * HTB, NXCD = 8, WGM = 8;

__host__ __device__ __forceinline__ int lds_byte(int r, int c) { const int st = (r >> 4) * 2 + (c >> 5), rr = r & 15, cc = c & 31, ob = rr * 64 + cc * 2; return st * 1024 + (ob ^ (((ob >> 9) & 1) << 5)); }
__host__ __device__ __forceinline__ void stage_rc(int b, int& R, int& C) { const int st = b / 1024, sb = b % 1024, swz = sb ^ (((sb >> 9) & 1) << 5); R = (st >> 1) * 16 + swz / 64; C = (st & 1) * 32 + (swz % 64) / 2; }
__host__ __device__ __forceinline__ int perm32(int rho) { const int n = rho >> 4, i = rho & 15; return 8 * (i >> 2) + 4 * n + (i & 3); }

struct Unit { const char* A; const char* B; const int* rows; int pm, pn, x0, x1; };

struct DenseOrder {
    const char* A; const char* Bt; int lda2, ldb2  , nM, nN, nwg, G, c;
    __device__ __forceinline__ void init(const void* A_, const void* Bt_, int lda, int ldb, int M, int N, int G_, int c_) { A = (const char*)A_; Bt = (const char*)Bt_; lda2 = lda * 2; ldb2 = ldb * 2; nM = M / BM; nN = N / BM; nwg = nM * nN; G = G_; c = c_; }
    __device__ __forceinline__ bool next(int i, Unit& u) const {
        const long L = (long)i * G + c; if (L >= nwg) return false;
        int wgid = (int)L; { const int q = nwg / NXCD, r = nwg % NXCD, xcd = wgid % NXCD, off = wgid / NXCD; wgid = (xcd < r ? xcd * (q + 1) : r * (q + 1) + (xcd - r) * q) + off; }
        const int nig = WGM * nN, gid = wgid / nig, fm = gid * WGM, gsz = (nM - fm) < WGM ? (nM - fm) : WGM;
        u.pm = fm + ((wgid % nig) % gsz); u.pn = (wgid % nig) / gsz;
        u.A = A + (size_t)u.pm * BM * lda2; u.B = Bt + (size_t)u.pn * BM * ldb2; u.rows = nullptr; u.x0 = i; u.x1 = 0; return true;
    }
    __device__ __forceinline__ int arow(const Unit&, int r) const { return r; }
};

__device__ __forceinline__ unsigned cvt_pk_bf16(float lo, float hi) { unsigned r; asm volatile("v_cvt_pk_bf16_f32 %0, %1, %2" : "=v"(r) : "v"(lo), "v"(hi)); return r; }
__device__ __forceinline__ float bf_lo(unsigned w) { return __builtin_bit_cast(float, w << 16); }
__device__ __forceinline__ float bf_hi(unsigned w) { return __builtin_bit_cast(float, w & 0xffff0000u); }
__device__ __forceinline__ float fast_sigmoid(float x) { return __builtin_amdgcn_rcpf(1.0f + __builtin_amdgcn_exp2f(-1.4426950408889634f * x)); }
__device__ __forceinline__ float gelu_tanh_f(float x) { const float u2 = 1.5957691216057308f * (x + 0.044715f * x * x * x); return x * fast_sigmoid(u2); }

__device__ __forceinline__ const char* uptr(const char* p) { const unsigned long long v = (unsigned long long)p;
    return (const char*)(((unsigned long long)(unsigned)__builtin_amdgcn_readfirstlane((int)(v >> 32)) << 32) | (unsigned)__builtin_amdgcn_readfirstlane((int)v)); }

template <class Epi, class Sched, bool ALIGN_EPI, bool GATHER, bool FP8 = false>
__device__ __forceinline__ void gemm_phase(PG8_LAS unsigned char* lds, const int wave, const int K, const int lda, const int ldb, const Sched& S, const Epi& E) {
    int tid; asm volatile("v_mbcnt_lo_u32_b32 %0, -1, 0\n\tv_mbcnt_hi_u32_b32 %0, -1, %0" : "=v"(tid)); tid += wave * 64; asm volatile("" : "+v"(tid));
    const int wid = wave, lane = tid & 63, wr = wid >> 2, wc = wid & 3, fr = lane & 15, fq = lane >> 4;
    constexpr int ESZ = FP8 ? 1 : 2;
    int nt = K * ESZ / (BK * 2); asm volatile("" : "+s"(nt));
    unsigned voffA[2][2], voffB[2];
#pragma unroll
    for (int i = 0; i < 2; ++i) { int R, C; stage_rc(tid * 16 + i * 8192, R, C); const int Rb = (R & ~31) + perm32(R & 31); voffB[i] = (unsigned)(Rb * ldb * ESZ + C * 2); }
    const size_t kstep = (size_t)(BK * 2);
    const size_t hstepB = (size_t)HALF * ldb * ESZ;
    const unsigned ldsw = (unsigned)wid * 1024u;
    const int aoff = lds_byte(wr * 64 + fr, FP8 ? fq * 16 : fq * 8), boff = lds_byte(wc * 32 + fr, FP8 ? fq * 16 : fq * 8);
    const int aoff1 = FP8 ? lds_byte(wr * 64 + fr, fq * 16 + 8) : aoff + 1024, boff1 = FP8 ? lds_byte(wc * 32 + fr, fq * 16 + 8) : boff + 1024;
#define PG8_SA(b, h) (((b) * 2 + (h)) * HTB)
#define PG8_SB(b, h) ((4 + (b) * 2 + (h)) * HTB)
#define PG8_STAGE(bufoff, gbase, voff) do { _Pragma("unroll") for (int _i = 0; _i < 2; ++_i) \
        __builtin_amdgcn_global_load_lds((const unsigned*)((const char*)(gbase) + (voff)[_i]), (PG8_LAS unsigned*)(lds + (bufoff) + ldsw + _i * 8192), 16, 0, 0); } while (0)
#define PG8_LD16(p) (*(const PG8_LAS v4i*)(p))
#define PG8_LDA(dst, b, h) do { _Pragma("unroll") for (int m = 0; m < 4; ++m) { if constexpr (FP8) dst##8[m] = __builtin_shufflevector(PG8_LD16(lds + PG8_SA(b, h) + aoff + m * 2048), PG8_LD16(lds + PG8_SA(b, h) + aoff1 + m * 2048), 0, 1, 2, 3, 4, 5, 6, 7); \
        else { dst[m][0] = *(const PG8_LAS bf16x8*)(lds + PG8_SA(b, h) + aoff + m * 2048); dst[m][1] = *(const PG8_LAS bf16x8*)(lds + PG8_SA(b, h) + aoff1 + m * 2048); } } } while (0)
#define PG8_LDB(dst, b, h) do { _Pragma("unroll") for (int n = 0; n < 2; ++n) { if constexpr (FP8) dst##8[n] = __builtin_shufflevector(PG8_LD16(lds + PG8_SB(b, h) + boff + n * 2048), PG8_LD16(lds + PG8_SB(b, h) + boff1 + n * 2048), 0, 1, 2, 3, 4, 5, 6, 7); \
        else { dst[n][0] = *(const PG8_LAS bf16x8*)(lds + PG8_SB(b, h) + boff + n * 2048); dst[n][1] = *(const PG8_LAS bf16x8*)(lds + PG8_SB(b, h) + boff1 + n * 2048); } } } while (0)
#define PG8_MMA(ai, bj, At, Bt) do { __builtin_amdgcn_s_setprio(1); _Pragma("unroll") for (int m = 0; m < 4; ++m) _Pragma("unroll") for (int n = 0; n < 2; ++n) { \
        if constexpr (FP8) acc[ai][bj][m][n] = __builtin_amdgcn_mfma_scale_f32_16x16x128_f8f6f4(Bt##8[n], At##8[m], acc[ai][bj][m][n], 0, 0, 0, f8sc, 0, f8sc); \
        else { _Pragma("unroll") for (int k = 0; k < 2; ++k) acc[ai][bj][m][n] = __builtin_amdgcn_mfma_f32_16x16x32_bf16(Bt[n][k], At[m][k], acc[ai][bj][m][n], 0, 0, 0); } } \
        __builtin_amdgcn_s_setprio(0); } while (0)
#define PG8_WAIT_V(n) asm volatile("s_waitcnt vmcnt(" #n ")" ::: "memory")
#define PG8_WAIT_L(n) asm volatile("s_waitcnt lgkmcnt(" #n ")" ::: "memory")
#define PG8_BAR __builtin_amdgcn_s_barrier()
#define PG8_SCHED __builtin_amdgcn_sched_barrier(0)
#define PG8_VOFF(dst, u) do { _Pragma("unroll") for (int _i = 0; _i < 2; ++_i) { int _R, _C; stage_rc(tid * 16 + _i * 8192, _R, _C); _Pragma("unroll") for (int _h = 0; _h < 2; ++_h) { \
        int _row = _R + _h * HALF; if constexpr (GATHER) _row = S.arow(u, _row); dst[_h][_i] = (unsigned)(_row * lda * ESZ + _C * 2); } } } while (0)
    int f8sc = 0x7F7F7F7F; asm volatile("" : "+v"(f8sc));
    Unit cur, nxt; int ui = 0;
    if (!S.next(0, cur)) return;
    f32x4 acc[2][2][4][2];
#pragma unroll
    for (int a = 0; a < 2; ++a)
#pragma unroll
        for (int b = 0; b < 2; ++b)
#pragma unroll
            for (int m = 0; m < 4; ++m)
#pragma unroll
                for (int n = 0; n < 2; ++n) acc[a][b][m][n] = (f32x4){0.f, 0.f, 0.f, 0.f};
    bf16x8 At[4][2], B0[2][2], B1[2][2]; v8i At8[4], B08[2], B18[2];
    PG8_VOFF(voffA, cur);
    const char* cA = cur.A; const char* cB = cur.B;
    PG8_STAGE(PG8_SB(0, 0), cB, voffB); PG8_STAGE(PG8_SB(0, 1), cB + hstepB, voffB); PG8_STAGE(PG8_SA(0, 0), cA, voffA[0]); PG8_STAGE(PG8_SA(0, 1), cA, voffA[1]);
    if (wr == 1) PG8_BAR;
    PG8_WAIT_V(2); PG8_BAR;
    PG8_STAGE(PG8_SB(1, 0), cB + kstep, voffB); PG8_STAGE(PG8_SA(1, 0), cA + kstep, voffA[0]); PG8_STAGE(PG8_SB(1, 1), cB + hstepB + kstep, voffB);
    PG8_WAIT_V(6); PG8_BAR;
    for (;;) {
        const bool has_next = S.next(ui + 1, nxt);
        const char* nA = has_next ? nxt.A : cA; const char* nB = has_next ? nxt.B : cB;
        for (int t = 0; t < nt; t += 2) {
            const bool last = (t == nt - 2);
            const char* a1 = uptr(cA + (size_t)(t + 1) * kstep);
            const char* a2 = uptr(last ? nA : cA + (size_t)(t + 2) * kstep); const char* b2 = uptr(last ? nB : cB + (size_t)(t + 2) * kstep);
            const char* a3 = a2 + kstep; const char* b3 = b2 + kstep;
            E.khook(acc, cur, t, nt, wr, fr);
            asm volatile("" : "+v"(voffA[0][0]), "+v"(voffA[0][1]), "+v"(voffA[1][0]), "+v"(voffA[1][1]), "+v"(voffB[0]), "+v"(voffB[1]));
            PG8_LDB(B0, 0, 0); PG8_LDB(B1, 0, 1); PG8_SCHED; PG8_LDA(At, 0, 0); PG8_STAGE(PG8_SA(1, 1), a1, voffA[1]);
            if constexpr (GATHER) { if (last && has_next) { PG8_VOFF(voffA, nxt); } }
            PG8_WAIT_V(8); PG8_WAIT_L(0); PG8_BAR; PG8_MMA(0, 0, At, B0); PG8_MMA(0, 1, At, B1); PG8_BAR; PG8_SCHED;
            PG8_LDA(At, 0, 1); PG8_STAGE(PG8_SB(0, 0), b2, voffB); PG8_STAGE(PG8_SB(0, 1), b2 + hstepB, voffB); PG8_STAGE(PG8_SA(0, 0), a2, voffA[0]);
            PG8_WAIT_V(8); PG8_WAIT_L(0); PG8_BAR; PG8_MMA(1, 0, At, B0); PG8_MMA(1, 1, At, B1); PG8_BAR; PG8_SCHED;
            PG8_LDB(B0, 1, 0); PG8_LDB(B1, 1, 1); PG8_SCHED; PG8_LDA(At, 1, 0); PG8_STAGE(PG8_SA(0, 1), a2, voffA[1]);
            PG8_WAIT_V(8); PG8_WAIT_L(0); PG8_BAR; PG8_MMA(0, 0, At, B0); PG8_MMA(0, 1, At, B1); PG8_BAR; PG8_SCHED;
            PG8_LDA(At, 1, 1); PG8_STAGE(PG8_SB(1, 0), b3, voffB); PG8_STAGE(PG8_SB(1, 1), b3 + hstepB, voffB); PG8_STAGE(PG8_SA(1, 0), a3, voffA[0]);
            PG8_WAIT_V(8); PG8_WAIT_L(0); PG8_BAR; PG8_MMA(1, 0, At, B0); PG8_MMA(1, 1, At, B1); PG8_BAR; PG8_SCHED;
        }
        if constexpr (ALIGN_EPI) { if (wr == 0) PG8_BAR; }
        if constexpr (FP8) { PG8_SCHED; asm volatile("s_nop 15\n\ts_nop 15\n\ts_nop 15" ::: "memory"); PG8_SCHED; }
        if constexpr (!Epi::AFTER_DRAIN) { E(acc, cur, wr, wc, fr, fq); }
        if (!has_next) break;
#pragma unroll
        for (int a = 0; a < 2; ++a)
#pragma unroll
            for (int b = 0; b < 2; ++b)
#pragma unroll
                for (int m = 0; m < 4; ++m)
#pragma unroll
                    for (int n = 0; n < 2; ++n) acc[a][b][m][n] = (f32x4){0.f, 0.f, 0.f, 0.f};
        cur = nxt; cA = nA; cB = nB; ++ui;
        if constexpr (ALIGN_EPI) { if (wr == 1) PG8_BAR; }
    }
    PG8_WAIT_V(0);
    if constexpr (!ALIGN_EPI) { if (wr == 0) PG8_BAR; }
    PG8_BAR;
    if constexpr (Epi::AFTER_DRAIN) { E.fused(acc, cur, wr, wc, fr, fq, lds); }
#undef PG8_SA
#undef PG8_SB
#undef PG8_STAGE
#undef PG8_LDA
#undef PG8_LDB
#undef PG8_MMA
#undef PG8_LD16
#undef PG8_WAIT_V
#undef PG8_WAIT_L
#undef PG8_BAR
#undef PG8_SCHED
#undef PG8_VOFF
}
}
namespace pg8 {
struct EpiBase {
    static constexpr bool AFTER_DRAIN = false;
    __device__ __forceinline__ void khook(f32x4 (&)[2][2][4][2], const Unit&, int, int, int, int) const {}
};
#define EPI_LOOP_ROWS for (int ai = 0; ai < 2; ++ai) _Pragma("unroll") for (int m = 0; m < 4; ++m)
typedef unsigned u32x2 __attribute__((ext_vector_type(2)));
__device__ __forceinline__ u32x2 pack8_fp8(const f32x4 v0, const f32x4 v1) { u32x2 w; unsigned a = 0, b = 0;
    a = __builtin_amdgcn_cvt_pk_fp8_f32(v0[0], v0[1], a, false); a = __builtin_amdgcn_cvt_pk_fp8_f32(v0[2], v0[3], a, true);
    b = __builtin_amdgcn_cvt_pk_fp8_f32(v1[0], v1[1], b, false); b = __builtin_amdgcn_cvt_pk_fp8_f32(v1[2], v1[3], b, true); w.x = a; w.y = b; return w; }
__device__ __forceinline__ u32x4 pack8(const f32x4 v0, const f32x4 v1) { u32x4 w; w.x = cvt_pk_bf16(v0[0], v0[1]); w.y = cvt_pk_bf16(v0[2], v0[3]); w.z = cvt_pk_bf16(v1[0], v1[1]); w.w = cvt_pk_bf16(v1[2], v1[3]); return w; }

struct EpiZ : EpiBase {
    bf16_t* Q; bf16_t* Ue; const float* r0; float c2;
    __device__ __forceinline__ void operator()(const f32x4 (&acc)[2][2][4][2], const Unit& u, int wr, int wc, int fr, int fq) const {
        const int sect = u.pn >> 2, colt = (u.pn & 3) * BM, row0 = u.pm * BM + wr * 64 + fr;
        bf16_t* base = Q + (size_t)sect * 16384 * 1024;
        const float sc = sect == 0 ? c2 : 1.f;
#pragma unroll
        EPI_LOOP_ROWS { const int row = row0 + ai * HALF + m * 16; const float rs = r0[row] * sc;
#pragma unroll
            for (int bj = 0; bj < 2; ++bj) { const int col = colt + bj * HALF + wc * 32 + 8 * fq;
                const u32x4 w = pack8(acc[ai][bj][m][0] * rs, acc[ai][bj][m][1] * rs);
                if (sect < 3) *(u32x4*)(base + (size_t)row * 1024 + col) = w;
                else { const int g = col >> 4, half = (col >> 3) & 1, b = row >> 12, t = row & 4095, c = t >> 4, j = t & 15;
                       *(u32x4*)(Ue + ((size_t)((g * 4 + b) * 256 + c) * 384 + j * 16 + half * 8)) = w; } } }
    }
};
struct EpiE {
    static constexpr bool AFTER_DRAIN = true;
    __device__ __forceinline__ void khook(f32x4 (&)[2][2][4][2], const Unit&, int, int, int, int) const {}
    __device__ __forceinline__ void fused(const f32x4 (&acc)[2][2][4][2], const Unit&, int wr, int wc, int fr, int fq, PG8_LAS unsigned char* lds) const {
        PG8_LAS float* Eo = (PG8_LAS float*)lds;
#pragma unroll
        EPI_LOOP_ROWS { const int row = wr * 64 + fr + ai * HALF + m * 16; const int col = wc * 32 + 8 * fq;
            *(PG8_LAS f32x4*)(Eo + row * 128 + col) = acc[ai][0][m][0]; *(PG8_LAS f32x4*)(Eo + row * 128 + col + 4) = acc[ai][0][m][1]; }
    }
};
struct EpiY : EpiBase {
    bf16_t* s1;
    __device__ __forceinline__ void operator()(const f32x4 (&acc)[2][2][4][2], const Unit& u, int wr, int wc, int fr, int fq) const {
        const int g = u.x0, b = u.x1;
#pragma unroll
        EPI_LOOP_ROWS { const int c = wr * 64 + fr + ai * HALF + m * 16;
#pragma unroll
            for (int bj = 0; bj < 2; ++bj) { const int col = bj * HALF + wc * 32 + 8 * fq, i = col >> 4, h0 = col & 15;
                f32x4 v0 = acc[ai][bj][m][0], v1 = acc[ai][bj][m][1];
#pragma unroll
                for (int q = 0; q < 4; ++q) { v0[q] = gelu_tanh_f(v0[q]); v1[q] = gelu_tanh_f(v1[q]); }
                *(u32x4*)(s1 + (size_t)(b * 4096 + c * 16 + i) * 1024 + g * 16 + h0) = pack8(v0, v1); } }
    }
};
struct EpiGlu : EpiBase {
    const bf16_t* s1; const float* bias; bf16_t* scat; float* ssq;
    __device__ __forceinline__ void operator()(const f32x4 (&acc)[2][2][4][2], const Unit& u, int wr, int wc, int fr, int fq) const {
        const int row0 = u.pm * BM + wr * 64 + fr, col0 = u.pn * BM + wc * 32 + 8 * fq;
        f32x4 bv[2][2];
#pragma unroll
        for (int bj = 0; bj < 2; ++bj)
#pragma unroll
            for (int n = 0; n < 2; ++n) bv[bj][n] = *(const f32x4*)(bias + col0 + bj * HALF + 4 * n);
#pragma unroll
        EPI_LOOP_ROWS { const int row = row0 + ai * HALF + m * 16; float q = 0.f;
#pragma unroll
            for (int bj = 0; bj < 2; ++bj) { const int col = col0 + bj * HALF;
                const u32x4 sv = *(const u32x4*)(s1 + (size_t)row * 1024 + col);
                f32x4 v0 = acc[ai][bj][m][0] + bv[bj][0], v1 = acc[ai][bj][m][1] + bv[bj][1];
                v0[0] = bf_lo(sv.x) * fast_sigmoid(v0[0]); v0[1] = bf_hi(sv.x) * fast_sigmoid(v0[1]); v0[2] = bf_lo(sv.y) * fast_sigmoid(v0[2]); v0[3] = bf_hi(sv.y) * fast_sigmoid(v0[3]);
                v1[0] = bf_lo(sv.z) * fast_sigmoid(v1[0]); v1[1] = bf_hi(sv.z) * fast_sigmoid(v1[1]); v1[2] = bf_lo(sv.w) * fast_sigmoid(v1[2]); v1[3] = bf_hi(sv.w) * fast_sigmoid(v1[3]);
                const u32x4 w = pack8(v0, v1); *(u32x4*)(scat + (size_t)row * 2048 + col) = w;
                const float e0 = bf_lo(w.x), e1 = bf_hi(w.x), e2 = bf_lo(w.y), e3 = bf_hi(w.y), e4 = bf_lo(w.z), e5 = bf_hi(w.z), e6 = bf_lo(w.w), e7 = bf_hi(w.w);
                q += (e0 * e0 + e1 * e1) + (e2 * e2 + e3 * e3) + (e4 * e4 + e5 * e5) + (e6 * e6 + e7 * e7); }
            q += __shfl_xor(q, 16); q += __shfl_xor(q, 32);
            if (fq == 0) ssq[(size_t)row * 16 + u.pn * 4 + wc] = q; }
    }
};
struct EpiRes1 {
    static constexpr bool AFTER_DRAIN = false;
    const float* x; bf16_t* x1b; unsigned char* x1f8; float* ssq; const PG8_LAS float* rsT;
    __device__ __forceinline__ void khook(f32x4 (&acc)[2][2][4][2], const Unit& u, int t, int nt, int wr, int fr) const {
        if (t * 2 == nt) {
#pragma unroll
            for (int ai = 0; ai < 2; ++ai)
#pragma unroll
                for (int m = 0; m < 4; ++m) { const float r = rsT[u.x0 * 256 + ai * HALF + wr * 64 + m * 16 + fr];
#pragma unroll
                    for (int bj = 0; bj < 2; ++bj)
#pragma unroll
                        for (int n = 0; n < 2; ++n) acc[ai][bj][m][n] = acc[ai][bj][m][n] * r; }
        }
    }
    __device__ __forceinline__ void operator()(const f32x4 (&acc)[2][2][4][2], const Unit& u, int wr, int wc, int fr, int fq) const {
        const int row0 = u.pm * BM + wr * 64 + fr, col0 = u.pn * BM + wc * 32 + 8 * fq;
#pragma unroll
        EPI_LOOP_ROWS { const int row = row0 + ai * HALF + m * 16; float s = 0.f;
#pragma unroll
            for (int bj = 0; bj < 2; ++bj) { const size_t off = (size_t)row * 2048 + col0 + bj * HALF;
                const u32x4 xv = __builtin_nontemporal_load((const u32x4*)(x1b + off));
                f32x4 v0 = acc[ai][bj][m][0], v1 = acc[ai][bj][m][1];
                v0[0] += bf_lo(xv.x); v0[1] += bf_hi(xv.x); v0[2] += bf_lo(xv.y); v0[3] += bf_hi(xv.y); v1[0] += bf_lo(xv.z); v1[1] += bf_hi(xv.z); v1[2] += bf_lo(xv.w); v1[3] += bf_hi(xv.w);
                s += (v0[0] * v0[0] + v0[1] * v0[1]) + (v0[2] * v0[2] + v0[3] * v0[3]) + (v1[0] * v1[0] + v1[1] * v1[1]) + (v1[2] * v1[2] + v1[3] * v1[3]);
                *(u32x4*)(x1b + off) = pack8(v0, v1); *(u32x2*)(x1f8 + off) = pack8_fp8(v0, v1); }
            s += __shfl_xor(s, 16); s += __shfl_xor(s, 32);
            if (fq == 0) ssq[(size_t)row * 32 + u.pn * 4 + wc] = s; }
    }
};
struct EpiPP : EpiBase {
    unsigned char* pp;
    __device__ __forceinline__ void operator()(const f32x4 (&acc)[2][2][4][2], const Unit& u, int wr, int wc, int fr, int fq) const {
        const int row0 = u.pm * BM + wr * 64 + fr, col0 = u.pn * BM + wc * 32 + 8 * fq;
#pragma unroll
        EPI_LOOP_ROWS { const int row = row0 + ai * HALF + m * 16;
#pragma unroll
            for (int bj = 0; bj < 2; ++bj) *(u32x2*)(pp + (size_t)row * 2048 + col0 + bj * HALF) = pack8_fp8(acc[ai][bj][m][0] * 16.f, acc[ai][bj][m][1] * 16.f); }
    }
};
struct EpiUp : EpiBase {
    const float* row_r; unsigned char* hmid;
    __device__ __forceinline__ void operator()(const f32x4 (&acc)[2][2][4][2], const Unit& u, int wr, int wc, int fr, int fq) const {
        const int rl0 = wr * 64 + fr, col = u.pn * HALF + wc * 32 + 8 * fq;
#pragma unroll
        EPI_LOOP_ROWS { const int rl = rl0 + ai * HALF + m * 16; const float r = row_r[u.x0 + rl] * 0.015625f;
            f32x4 o0, o1;
#pragma unroll
            for (int q = 0; q < 4; ++q) { const float a = acc[ai][0][m][0][q] * r, b = acc[ai][1][m][0][q] * r; o0[q] = a * fast_sigmoid(a) * b;
                                          const float c = acc[ai][0][m][1][q] * r, d = acc[ai][1][m][1][q] * r; o1[q] = c * fast_sigmoid(c) * d; }
            if (rl >= u.pm) { o0 = (f32x4){0.f, 0.f, 0.f, 0.f}; o1 = o0; }
            *(u32x2*)(hmid + (size_t)(u.x1 * BM + rl) * 512 + col) = pack8_fp8(o0, o1); }
    }
};
struct EpiDown : EpiBase {
    const int* row_ts; const float* row_w; unsigned char* contrib;
    __device__ __forceinline__ void operator()(const f32x4 (&acc)[2][2][4][2], const Unit& u, int wr, int wc, int fr, int fq) const {
        const int rl0 = wr * 64 + fr, col0 = u.pn * BM + wc * 32 + 8 * fq;
#pragma unroll
        EPI_LOOP_ROWS { const int rl = rl0 + ai * HALF + m * 16;
            if (rl < u.x1) { const int ts = row_ts[u.x0 + rl]; const float w = row_w[u.x0 + rl] * 0.5f;
                unsigned char* dst = contrib + ((size_t)(ts & 1) * 16384 + (size_t)(ts >> 1)) * 2048 + col0;
#pragma unroll
                for (int bj = 0; bj < 2; ++bj) *(u32x2*)(dst + bj * HALF) = pack8_fp8(acc[ai][bj][m][0] * w, acc[ai][bj][m][1] * w); } }
    }
};
struct EpiGate : EpiBase {
    const bf16_t* x2b; const unsigned char* pp; const float* r2; bf16_t* x3b; float* ssq;
    __device__ __forceinline__ void operator()(const f32x4 (&acc)[2][2][4][2], const Unit& u, int wr, int wc, int fr, int fq) const {
        const int row0 = u.pm * BM + wr * 64 + fr, col0 = u.pn * BM + wc * 32 + 8 * fq;
#pragma unroll
        EPI_LOOP_ROWS { const int row = row0 + ai * HALF + m * 16; const float r = r2[row] * 0.015625f; float s = 0.f;
#pragma unroll
            for (int bj = 0; bj < 2; ++bj) { const size_t off = (size_t)row * 2048 + col0 + bj * HALF;
                const u32x4 xv = __builtin_nontemporal_load((const u32x4*)(x2b + off)); const u32x2 pv = __builtin_nontemporal_load((const u32x2*)(pp + off));
                const f32x2 p01 = __builtin_amdgcn_cvt_pk_f32_fp8(pv.x, false), p23 = __builtin_amdgcn_cvt_pk_f32_fp8(pv.x, true), p45 = __builtin_amdgcn_cvt_pk_f32_fp8(pv.y, false), p67 = __builtin_amdgcn_cvt_pk_f32_fp8(pv.y, true);
                f32x4 v0, v1;
                v0[0] = bf_lo(xv.x) + fast_sigmoid(acc[ai][bj][m][0][0] * r) * (p01[0] * 0.0625f); v0[1] = bf_hi(xv.x) + fast_sigmoid(acc[ai][bj][m][0][1] * r) * (p01[1] * 0.0625f);
                v0[2] = bf_lo(xv.y) + fast_sigmoid(acc[ai][bj][m][0][2] * r) * (p23[0] * 0.0625f); v0[3] = bf_hi(xv.y) + fast_sigmoid(acc[ai][bj][m][0][3] * r) * (p23[1] * 0.0625f);
                v1[0] = bf_lo(xv.z) + fast_sigmoid(acc[ai][bj][m][1][0] * r) * (p45[0] * 0.0625f); v1[1] = bf_hi(xv.z) + fast_sigmoid(acc[ai][bj][m][1][1] * r) * (p45[1] * 0.0625f);
                v1[2] = bf_lo(xv.w) + fast_sigmoid(acc[ai][bj][m][1][2] * r) * (p67[0] * 0.0625f); v1[3] = bf_hi(xv.w) + fast_sigmoid(acc[ai][bj][m][1][3] * r) * (p67[1] * 0.0625f);
                s += (v0[0] * v0[0] + v0[1] * v0[1]) + (v0[2] * v0[2] + v0[3] * v0[3]) + (v1[0] * v1[0] + v1[1] * v1[1]) + (v1[2] * v1[2] + v1[3] * v1[3]);
                *(u32x4*)(x3b + off) = pack8(v0, v1); }
            s += __shfl_xor(s, 16); s += __shfl_xor(s, 32);
            if (fq == 0) ssq[(size_t)row * 32 + u.pn * 4 + wc] = s; }
    }
};
#undef EPI_LOOP_ROWS
}
namespace attn_body {
using bf16=__hip_bfloat16;
using bf16x8=__attribute__((ext_vector_type(8)))short;
using s16x4=__attribute__((ext_vector_type(4)))short;
using f32x16=__attribute__((ext_vector_type(16)))float;
using u32x4=__attribute__((ext_vector_type(4)))unsigned;
constexpr int SEQ=4096,D=64,DM=1024,SPITCH=2048;
constexpr int NW=8,QBLK=32,QB=128,KVBLK=64,NQB=SEQ/QB;
constexpr int LUTN=384;
__device__ __forceinline__ int crow(int r,int hi){return (r&3)+8*(r>>2)+4*hi;}
#define SBAR() __builtin_amdgcn_sched_barrier(0)
typedef __attribute__((address_space(3))) const char* lds_cptr;
typedef __attribute__((address_space(3))) const float* lds_fptr;
__device__ __forceinline__ void cmask(f32x16&p0,f32x16&p1,int jb,int qrel,int hi){
  const float NEG=-INFINITY; int kb=64*jb+4*hi;
  #pragma unroll
  for(int r=0;r<16;++r){int kv=kb+(r&3)+8*(r>>2); if(kv>qrel)p0[r]=NEG; if(kv+32>qrel)p1[r]=NEG;}
}
__device__ __forceinline__ void cbias(f32x16&p0,f32x16&p1,int jb,int qrel,int hi,lds_fptr lut){
  const lds_fptr pb=lut+(qrel-64*jb-4*hi+68);
  #pragma unroll
  for(int g=0;g<4;++g){
    #pragma unroll
    for(int q=0;q<4;++q){const int r=4*g+q, ko=(r&3)+8*(r>>2); p0[r]+=pb[59-ko]; p1[r]+=pb[27-ko];}
    __builtin_amdgcn_sched_barrier(0);
  }
}
constexpr int NSLOT=3, KSLOT=8192, VSLOT=16384;
constexpr int LDS_K0=0, LDS_K1=NSLOT*KSLOT, LDS_V=2*NSLOT*KSLOT, LDS_WS=LDS_V+NSLOT*VSLOT, LDS_Q=LDS_WS+NW*64*4, LDS_LUT=LDS_Q+NW*4096, LDS_BYTES=LDS_LUT+1536;
constexpr int LDS_Y0=0, LDS_Y1=65536;
static_assert(LDS_Y1+65536<=LDS_LUT,"stage overlaps the bias table");
typedef float f32x4e __attribute__((ext_vector_type(4))); typedef unsigned u32x2e __attribute__((ext_vector_type(2)));
constexpr float C2=0.125f*1.4426950408889634f;
__device__ __forceinline__ void glds16(const void*gsrc,unsigned lds_dst){unsigned keep;
  asm volatile("s_mov_b32 %0, m0\n\ts_mov_b32 m0, %2\n\ts_nop 0\n\tglobal_load_lds_dwordx4 %1, off\n\ts_mov_b32 m0, %0":"=&s"(keep):"v"(gsrc),"s"(lds_dst):"memory");}
__device__ __forceinline__ float max3f(float a,float b,float c){float r;asm("v_max3_f32 %0, %1, %2, %3":"=v"(r):"v"(a),"v"(b),"v"(c));return r;}
__device__ __forceinline__ float max2f(float a,float b){float r;asm("v_max_f32_e32 %0, %1, %2":"=v"(r):"v"(a),"v"(b));return r;}
__device__ __forceinline__ float fadd_s(float a,float b){float r;asm("v_add_f32_e32 %0, %1, %2":"=v"(r):"v"(a),"v"(b));return r;}
__device__ __forceinline__ float fsub_s(float a,float b){float r;asm("v_sub_f32_e32 %0, %1, %2":"=v"(r):"v"(a),"v"(b));return r;}
typedef float f32x2_t __attribute__((ext_vector_type(2))); typedef __bf16 bf16x2_t __attribute__((ext_vector_type(2)));
__device__ __forceinline__ unsigned cvtpk_s(float lo,float hi){f32x2_t v={lo,hi};bf16x2_t b=__builtin_convertvector(v,bf16x2_t);return __builtin_bit_cast(unsigned,b);}
#define WAIT_BAR(N) asm volatile("s_waitcnt vmcnt(" #N ") lgkmcnt(0)\n\ts_barrier":::"memory")
#define LDSB8(p) (*(const __attribute__((address_space(3))) bf16x8*)(p))
__device__ __forceinline__ void qkt(f32x16&p0,f32x16&p1,lds_cptr kp,lds_cptr qp,const f32x16&negm){
  #pragma unroll
  for(int d0=0;d0<4;++d0){
    const bf16x8 b0=LDSB8(kp+d0*2048), b1=LDSB8(kp+d0*2048+512), qf=LDSB8(qp+d0*1024);
    if(d0==0){p0=__builtin_amdgcn_mfma_f32_32x32x16_bf16(b0,qf,negm,0,0,0);p1=__builtin_amdgcn_mfma_f32_32x32x16_bf16(b1,qf,negm,0,0,0);}
    else{p0=__builtin_amdgcn_mfma_f32_32x32x16_bf16(b0,qf,p0,0,0,0);p1=__builtin_amdgcn_mfma_f32_32x32x16_bf16(b1,qf,p1,0,0,0);}}
}
typedef short v4i16_t __attribute__((ext_vector_type(4)));
__device__ __forceinline__ void kload8(bf16x8*kf,lds_cptr kp){
  kf[0]=LDSB8(kp);      kf[1]=LDSB8(kp+512);  kf[2]=LDSB8(kp+2048); kf[3]=LDSB8(kp+2560);
  kf[4]=LDSB8(kp+4096); kf[5]=LDSB8(kp+4608); kf[6]=LDSB8(kp+6144); kf[7]=LDSB8(kp+6656);
}
__device__ __forceinline__ void kload2(bf16x8*kf,lds_cptr kp,int j){ kf[2*j]=LDSB8(kp+j*2048); kf[2*j+1]=LDSB8(kp+j*2048+512); }
__device__ __forceinline__ s16x4 vtr(lds_cptr p){ return __builtin_bit_cast(s16x4,__builtin_amdgcn_ds_read_tr16_b64_v4i16((__attribute__((address_space(3))) v4i16_t*)p)); }
__device__ __forceinline__ float rowmax(const f32x16&p0,const f32x16&p1){
  float a=max3f(p0[0],p0[1],p1[0]),b=max3f(p0[2],p0[3],p1[1]);a=max3f(a,p1[2],p1[3]);
  #pragma unroll
  for(int r=4;r<16;r+=4){a=max3f(a,p0[r],p0[r+1]);b=max3f(b,p0[r+2],p0[r+3]);a=max3f(a,p1[r],p1[r+1]);b=max3f(b,p1[r+2],p1[r+3]);}
  const float m=max2f(a,b);
  auto rr=__builtin_amdgcn_permlane32_swap(__float_as_uint(m),__float_as_uint(m),false,false);
  return max2f(__uint_as_float(rr[0]),__uint_as_float(rr[1]));
}
__device__ __forceinline__ void pv4(f32x16*o,lds_cptr vp,bf16x8 pa0,bf16x8 pa1,bf16x8 pa2,bf16x8 pa3){
  #pragma unroll
  for(int d0=0;d0<4;++d0){s16x4 lo[4],hi[4];
    #pragma unroll
    for(int ks=0;ks<4;++ks){ lo[ks]=vtr(vp+d0*4096+ks*1024); hi[ks]=vtr(vp+d0*4096+ks*1024+512); }
    #define PK(k) (bf16x8){lo[k][0],lo[k][1],lo[k][2],lo[k][3],hi[k][0],hi[k][1],hi[k][2],hi[k][3]}
    o[d0]=__builtin_amdgcn_mfma_f32_32x32x16_bf16(pa0,PK(0),o[d0],0,0,0);
    o[d0]=__builtin_amdgcn_mfma_f32_32x32x16_bf16(pa1,PK(1),o[d0],0,0,0);
    o[d0]=__builtin_amdgcn_mfma_f32_32x32x16_bf16(pa2,PK(2),o[d0],0,0,0);
    o[d0]=__builtin_amdgcn_mfma_f32_32x32x16_bf16(pa3,PK(3),o[d0],0,0,0);
    #undef PK
  }
}

template<int THRL> __device__ __forceinline__ void attn_unit(int b,int h,int qb,const bf16*Q,const bf16*__restrict__ K,const bf16*__restrict__ V,bf16*scat,const float*lutg,const float*subg,float nlam,char*shm,int wave){
  int tid; asm volatile("v_mbcnt_lo_u32_b32 %0, -1, 0\n\tv_mbcnt_hi_u32_b32 %0, -1, %0":"=v"(tid)); tid+=wave*64;
  const int lane=tid&63,r32=lane&31,hi=lane>>5; const int wid=wave; const int cm=wid>>2,wq=wid&3;
  const long rowbase=(long)b*SEQ; const int q0=qb*QB;
  const bf16*Qw=Q+(rowbase+q0+wq*QBLK)*DM+(2*h+cm)*D;
  const bf16*Kh=K+rowbase*DM+(2*h)*D,*Vh=V+rowbase*DM+h*128;
  const unsigned lds0=(unsigned)(uintptr_t)shm;
  float*wsf=(float*)(shm+LDS_WS)+wid*64;
  const bf16*ksrc=Kh+(long)lane*DM+wid*8;
  const bf16*vsrc=Vh+(long)(16*(wid&3)+(lane>>2))*DM+(wid>>2)*32+(lane&3)*8;
  const unsigned kdst=lds0+LDS_K0+wid*1024, vdst=lds0+LDS_V+wid*1024;
  #define DMA_K(t,slot) do{ glds16(ksrc+(long)(t)*KVBLK*DM,(unsigned)__builtin_amdgcn_readfirstlane(kdst+(slot))); glds16(ksrc+D+(long)(t)*KVBLK*DM,(unsigned)__builtin_amdgcn_readfirstlane(kdst+LDS_K1+(slot))); }while(0)
  #define DMA_V(t,slot) do{ glds16(vsrc+(long)(t)*KVBLK*DM,(unsigned)__builtin_amdgcn_readfirstlane(vdst+2*(slot))); glds16(vsrc+64+(long)(t)*KVBLK*DM,(unsigned)__builtin_amdgcn_readfirstlane(vdst+8192+2*(slot))); }while(0)
  bf16x8 kf[8];
  const lds_cptr shm3=(lds_cptr)shm; const lds_cptr kp0=shm3+(cm?LDS_K1:LDS_K0)+hi*1024+r32*16; const lds_cptr vp0=shm3+LDS_V+((lane>>4)&1)*32+(lane&3)*8+(4*hi+((lane&15)>>2))*64;
  const lds_cptr qp=shm3+LDS_Q+wid*4096+lane*16;
  const int NT=(q0+QB)/KVBLK;
  const lds_fptr lut=(lds_fptr)(shm3+LDS_LUT);
  if(tid<LUTN)((__attribute__((address_space(3))) float*)(shm3+LDS_LUT))[tid]=lutg[tid];
  #pragma unroll
  for(int d0=0;d0<4;++d0) glds16(Qw+(long)r32*DM+d0*16+hi*8,(unsigned)__builtin_amdgcn_readfirstlane(lds0+LDS_Q+wid*4096+d0*1024));
  DMA_K(0,0);DMA_V(0,0);DMA_K(1,KSLOT);
  float mhat=0.f,l_reg=0.f;f32x16 o[4];o[0]=f32x16{};o[1]=f32x16{};o[2]=f32x16{};o[3]=f32x16{};f32x16 negm=f32x16{};asm volatile("":"+v"(negm));
  const int qrel=wq*QBLK+r32;
  #define CMASK(P0,P1,t) do{int jb_=(t)-(NT-2); if(jb_>=-2){ if(wq*QBLK-64*jb_-63<128)cbias(P0,P1,jb_,qrel,hi,lut); if(jb_>=0)cmask(P0,P1,jb_,qrel,hi);} }while(0)
  bool resc=false;
  #define RESC() do{ if(resc){ asm volatile("s_waitcnt lgkmcnt(0)":::"memory"); \
      _Pragma("unroll") for(int d_=0;d_<4;++d_) _Pragma("unroll") for(int r=0;r<16;++r)o[d_][r]*=wsf[crow(r,hi)]; } }while(0)
  f32x16 c0,c1; u32x4 pa0,pa1,pa2,pa3,pb0,pb1,pb2,pb3;
  int sl_prev=0,sl_cur=0,sl_next=KSLOT;
  #define ROT() do{sl_prev=sl_cur;sl_cur=sl_next;sl_next=(sl_next==(NSLOT-1)*KSLOT)?0:sl_next+KSLOT;}while(0)
  if(NT>2){ DMA_K(2,2*KSLOT); WAIT_BAR(6); }
  else { WAIT_BAR(4); }
  #define PKW(P,B) cvtpk_s(P[B],P[B+1])
  qkt(c0,c1,kp0,qp,negm);asm volatile("s_nop 15\n\ts_nop 7":"+v"(c0),"+v"(c1));CMASK(c0,c1,0);
  { const float rm=rowmax(c0,c1); mhat=fadd_s(mhat,rm);
    _Pragma("unroll") for(int r=0;r<16;++r){c0[r]=fsub_s(c0[r],rm);c1[r]=fsub_s(c1[r],rm);}
    _Pragma("unroll") for(int r=0;r<16;++r)negm[r]=-mhat; asm volatile("":"+v"(negm));
    _Pragma("unroll") for(int r=0;r<16;++r){c0[r]=__builtin_amdgcn_exp2f(c0[r]);c1[r]=__builtin_amdgcn_exp2f(c1[r]);}
    float sacc=c0[0]+c0[1]; _Pragma("unroll") for(int r=2;r<16;++r)sacc+=c0[r]; _Pragma("unroll") for(int r=0;r<16;++r)sacc+=c1[r]; l_reg+=sacc;
    pa0=(u32x4){PKW(c0,0),PKW(c0,2),PKW(c0,4),PKW(c0,6)};pa1=(u32x4){PKW(c0,8),PKW(c0,10),PKW(c0,12),PKW(c0,14)};pa2=(u32x4){PKW(c1,0),PKW(c1,2),PKW(c1,4),PKW(c1,6)};pa3=(u32x4){PKW(c1,8),PKW(c1,10),PKW(c1,12),PKW(c1,14)}; }
  WAIT_BAR(0);
  if(NT>2){DMA_K(3,0);} DMA_V(1,KSLOT);
  ROT();
  kload8(kf,kp0+sl_cur);
  if(NT>2){ WAIT_BAR(4); }
  else { WAIT_BAR(0); }
  s16x4 vlo[8],vhi[8];
  #define PAF(w) __builtin_bit_cast(bf16x8,w)
  #define VFR(i) (bf16x8){vlo[i][0],vlo[i][1],vlo[i][2],vlo[i][3],vhi[i][0],vhi[i][1],vhi[i][2],vhi[i][3]}
  #define PIN(x) asm volatile("":"+v"(x))
  #define MX3(a,b,c) __builtin_fmaxf(__builtin_fmaxf((a),(b)),(c))
  #define EX(v) __builtin_amdgcn_exp2f(v)
  #define VRD(i,kk) do{ vlo[i]=vtr(vp_+(((i)&3)*4096+(2*(kk)+((i)>>2))*1024)); vhi[i]=vtr(vp_+(((i)&3)*4096+(2*(kk)+((i)>>2))*1024+512)); }while(0)
  #define GAPA(MF,i) do{ VRD(i,0); SBAR(); MF; SBAR(); }while(0)
  #define GAPB(MF,X,B,PW,J) do{ MF; X[B]=EX(X[B]); X[B+1]=EX(X[B+1]); sacc+=X[B]; sacc+=X[B+1]; PIN(sacc); PW[J]=PKW(X,B); PIN(PW); SBAR(); }while(0)
  #define KRD(G,j) do{ if(G){ kload2(kf,kp0+sl_next,j); SBAR(); } }while(0)
  #define SOFT(X,B,PW,J) do{ X[B]=EX(X[B]); X[B+1]=EX(X[B+1]); sacc+=X[B]; sacc+=X[B+1]; PIN(sacc); PW[J]=PKW(X,B); PIN(PW); SBAR(); }while(0)
  #define MFO(MF) do{ MF; SBAR(); }while(0)
  #define STEP(PO0,PO1,PO2,PO3,PN0,PN1,PN2,PN3,t,GK,GV,GL) do{ SBAR(); \
    const lds_cptr vp_=vp0+2*sl_prev; bf16x8 qf; \
    qf=LDSB8(qp);      GAPA(c0=__builtin_amdgcn_mfma_f32_32x32x16_bf16(kf[0],qf,negm,0,0,0),0); GAPA(c1=__builtin_amdgcn_mfma_f32_32x32x16_bf16(kf[1],qf,negm,0,0,0),1); \
    qf=LDSB8(qp+1024); GAPA(c0=__builtin_amdgcn_mfma_f32_32x32x16_bf16(kf[2],qf,c0,0,0,0),2);   GAPA(c1=__builtin_amdgcn_mfma_f32_32x32x16_bf16(kf[3],qf,c1,0,0,0),3); \
    qf=LDSB8(qp+2048); GAPA(c0=__builtin_amdgcn_mfma_f32_32x32x16_bf16(kf[4],qf,c0,0,0,0),4);   GAPA(c1=__builtin_amdgcn_mfma_f32_32x32x16_bf16(kf[5],qf,c1,0,0,0),5); \
    qf=LDSB8(qp+3072); GAPA(c0=__builtin_amdgcn_mfma_f32_32x32x16_bf16(kf[6],qf,c0,0,0,0),6);   GAPA(c1=__builtin_amdgcn_mfma_f32_32x32x16_bf16(kf[7],qf,c1,0,0,0),7); \
    if(GK){DMA_K((t)+3,sl_cur);} if(GV){DMA_V((t)+1,sl_next);} \
    CMASK(c0,c1,t); \
    { float a=MX3(c0[0],c0[1],c1[0]),b_=MX3(c0[2],c0[3],c1[1]); a=MX3(a,c1[2],c1[3]); \
      _Pragma("unroll") for(int r=4;r<16;r+=4){a=MX3(a,c0[r],c0[r+1]);b_=MX3(b_,c0[r+2],c0[r+3]);a=MX3(a,c1[r],c1[r+1]);b_=MX3(b_,c1[r+2],c1[r+3]);} \
      float rm=__builtin_fmaxf(a,b_); { auto rr=__builtin_amdgcn_permlane32_swap(__float_as_uint(rm),__float_as_uint(rm),false,false); rm=__builtin_fmaxf(__uint_as_float(rr[0]),__uint_as_float(rr[1])); } \
      resc=false; \
      if(__builtin_expect(__any(rm>(float)THRL),0)){ const float dl=__builtin_fmaxf(rm,0.f); mhat+=dl; \
        _Pragma("unroll") for(int r=0;r<16;++r){c0[r]-=dl;c1[r]-=dl;} \
        _Pragma("unroll") for(int r=0;r<16;++r)negm[r]=-mhat; asm volatile("":"+v"(negm)); \
        const float f=__builtin_amdgcn_exp2f(-dl); l_reg*=f; if(hi==0)wsf[r32]=f; resc=true; } } \
    SBAR(); float sacc=0.f; \
    SOFT(c0,0,PN0,0); SOFT(c0,2,PN0,1); SOFT(c0,4,PN0,2); SOFT(c0,6,PN0,3); SOFT(c0,8,PN1,0); SOFT(c0,10,PN1,1); SOFT(c0,12,PN1,2); SOFT(c0,14,PN1,3); \
    SOFT(c1,0,PN2,0); SOFT(c1,2,PN2,1); SOFT(c1,4,PN2,2); SOFT(c1,6,PN2,3); SOFT(c1,8,PN3,0); SOFT(c1,10,PN3,1); SOFT(c1,12,PN3,2); SOFT(c1,14,PN3,3); \
    SBAR(); asm volatile("s_nop 7"); SBAR(); \
    MFO(o[0]=__builtin_amdgcn_mfma_f32_32x32x16_bf16(PAF(PO0),VFR(0),o[0],0,0,0));  VRD(0,1); SBAR(); \
    MFO(o[1]=__builtin_amdgcn_mfma_f32_32x32x16_bf16(PAF(PO0),VFR(1),o[1],0,0,0));  VRD(1,1); SBAR(); \
    MFO(o[2]=__builtin_amdgcn_mfma_f32_32x32x16_bf16(PAF(PO0),VFR(2),o[2],0,0,0));  VRD(2,1); SBAR(); \
    MFO(o[3]=__builtin_amdgcn_mfma_f32_32x32x16_bf16(PAF(PO0),VFR(3),o[3],0,0,0));  VRD(3,1); SBAR(); \
    MFO(o[0]=__builtin_amdgcn_mfma_f32_32x32x16_bf16(PAF(PO1),VFR(4),o[0],0,0,0));  VRD(4,1); SBAR(); \
    MFO(o[1]=__builtin_amdgcn_mfma_f32_32x32x16_bf16(PAF(PO1),VFR(5),o[1],0,0,0)); VRD(5,1); SBAR(); \
    MFO(o[2]=__builtin_amdgcn_mfma_f32_32x32x16_bf16(PAF(PO1),VFR(6),o[2],0,0,0)); VRD(6,1); SBAR(); \
    MFO(o[3]=__builtin_amdgcn_mfma_f32_32x32x16_bf16(PAF(PO1),VFR(7),o[3],0,0,0)); VRD(7,1); SBAR(); \
    MFO(o[0]=__builtin_amdgcn_mfma_f32_32x32x16_bf16(PAF(PO2),VFR(0),o[0],0,0,0)); \
    KRD(GL,0); MFO(o[1]=__builtin_amdgcn_mfma_f32_32x32x16_bf16(PAF(PO2),VFR(1),o[1],0,0,0)); \
    KRD(GL,1); MFO(o[2]=__builtin_amdgcn_mfma_f32_32x32x16_bf16(PAF(PO2),VFR(2),o[2],0,0,0)); \
    KRD(GL,2); MFO(o[3]=__builtin_amdgcn_mfma_f32_32x32x16_bf16(PAF(PO2),VFR(3),o[3],0,0,0)); \
    KRD(GL,3); MFO(o[0]=__builtin_amdgcn_mfma_f32_32x32x16_bf16(PAF(PO3),VFR(4),o[0],0,0,0)); \
    MFO(o[1]=__builtin_amdgcn_mfma_f32_32x32x16_bf16(PAF(PO3),VFR(5),o[1],0,0,0)); \
    MFO(o[2]=__builtin_amdgcn_mfma_f32_32x32x16_bf16(PAF(PO3),VFR(6),o[2],0,0,0)); \
    MFO(o[3]=__builtin_amdgcn_mfma_f32_32x32x16_bf16(PAF(PO3),VFR(7),o[3],0,0,0)); \
    l_reg+=sacc; \
    }while(0)
  int t=1;
  #undef CMASK
  #define CMASK(P0,P1,t) do{}while(0)
  for(;t+5<NT;t+=2){
    STEP(pa0,pa1,pa2,pa3,pb0,pb1,pb2,pb3,t,true,true,true);     WAIT_BAR(4); RESC(); ROT();
    STEP(pb0,pb1,pb2,pb3,pa0,pa1,pa2,pa3,t+1,true,true,true);   WAIT_BAR(4); RESC(); ROT();
  }
  #undef CMASK
  #define CMASK(P0,P1,t) do{int jb_=(t)-(NT-2); if(jb_>=-2){ if(wq*QBLK-64*jb_-63<128)cbias(P0,P1,jb_,qrel,hi,lut); if(jb_>=0)cmask(P0,P1,jb_,qrel,hi);} }while(0)
  #define ENDW(tt) do{ if((tt)+3<NT){WAIT_BAR(4);} else if((tt)+2<NT){WAIT_BAR(2);} else {WAIT_BAR(0);} }while(0)
  for(;t+1<NT;t+=2){
    STEP(pa0,pa1,pa2,pa3,pb0,pb1,pb2,pb3,t,(t+3<NT),(t+1<NT),(t+1<NT));       ENDW(t);   RESC(); ROT();
    STEP(pb0,pb1,pb2,pb3,pa0,pa1,pa2,pa3,t+1,(t+4<NT),(t+2<NT),(t+2<NT));     ENDW(t+1); RESC(); ROT();
  }
  STEP(pa0,pa1,pa2,pa3,pb0,pb1,pb2,pb3,NT-1,false,false,false); RESC();
  SBAR(); pv4(o,vp0+2*sl_cur,PAF(pb0),PAF(pb1),PAF(pb2),PAF(pb3));
  #undef PKW
  #undef PAF
  #undef VFR
  #undef PIN
  #undef MX3
  #undef GAPA
  #undef GAPB
  #undef SOFT
  #undef MFO
  #undef EX
  #undef VRD
  #undef KRD
  #undef STEP
  #undef ENDW
  {auto rr=__builtin_amdgcn_permlane32_swap(__float_as_uint(l_reg),__float_as_uint(l_reg),false,false);l_reg=__uint_as_float(rr[0])+__uint_as_float(rr[1]);}
  if(hi==0)wsf[32+r32]=l_reg;
  { const float sc=cm?nlam:1.f; asm volatile("s_waitcnt lgkmcnt(0)":::"memory");
    #pragma unroll
    for(int r=0;r<16;++r){ const float rl=__builtin_amdgcn_rcpf(wsf[32+crow(r,hi)])*sc;
      #pragma unroll
      for(int d0=0;d0<4;++d0)o[d0][r]*=rl; } }
  asm volatile("s_waitcnt lgkmcnt(0)\n\ts_barrier":::"memory");
  { float*stg=(float*)(shm+(cm?LDS_Y1:LDS_Y0))+wq*QBLK*128;
    #pragma unroll
    for(int r=0;r<16;++r){const int orow=crow(r,hi);
      #pragma unroll
      for(int d0=0;d0<4;++d0)stg[orow*128+d0*32+r32]=o[d0][r];} }
  asm volatile("s_waitcnt lgkmcnt(0)\n\ts_barrier":::"memory");
  { int l2; asm volatile("v_mbcnt_lo_u32_b32 %0, -1, 0\n\tv_mbcnt_hi_u32_b32 %0, -1, %0":"=v"(l2)); const int half=l2>>5,c4=l2&31;
    const __attribute__((address_space(1))) f32x4e*gp=(const __attribute__((address_space(1))) f32x4e*)(subg+c4*4); asm volatile("":"+v"(gp)); const f32x4e g4=*gp;
    #pragma unroll
    for(int p=0;p<8;++p){ const int row=wave*16+2*p+half;
      const f32x4e a=*(const __attribute__((address_space(3))) f32x4e*)(shm3+LDS_Y0+(row*128+c4*4)*4), c=*(const __attribute__((address_space(3))) f32x4e*)(shm3+LDS_Y1+(row*128+c4*4)*4);
      const f32x4e v=a+c; float q=v[0]*v[0]+v[1]*v[1]+v[2]*v[2]+v[3]*v[3];
      q+=__shfl_xor(q,1); q+=__shfl_xor(q,2); q+=__shfl_xor(q,4); q+=__shfl_xor(q,8); q+=__shfl_xor(q,16);
      const float rs=__builtin_amdgcn_rsqf(q*(1.f/128.f)+1e-5f)*0.8f;
      u32x2e w; w[0]=cvtpk_s(v[0]*rs*g4[0],v[1]*rs*g4[1]); w[1]=cvtpk_s(v[2]*rs*g4[2],v[3]*rs*g4[3]);
      *(u32x2e*)(scat+(rowbase+q0+row)*SPITCH+1024+h*128+c4*4)=w; } }
  asm volatile("s_waitcnt lgkmcnt(0)\n\ts_barrier":::"memory");
  #undef DMA_K
  #undef DMA_V
  #undef CMASK
  #undef RESC
  #undef ROT
}
constexpr int ATTN_LDS_BYTES=LDS_BYTES;
struct AttnTensors { const bf16* Q; const bf16* K; const bf16* V; bf16* scat; const float* lutg; const float* subg; const float* nlam; };
struct AttnUnit { int bh; int qb; };
struct StaticOrder {
  int vcu;
  __device__ __forceinline__ explicit StaticOrder(int grid,int block):vcu((grid%8==0)?(block%8)*(grid/8)+block/8:block){}
  __device__ __forceinline__ bool next(int i,AttnUnit&u)const{ if(i>=4||vcu>=256)return false; const int s=vcu&7; u.bh=vcu>>3; u.qb=(i==0)?s:(i==1)?15-s:(i==2)?16+s:31-s; return true; }
};
template<class Sched,class Hook,int THRL=8> __device__ __forceinline__ void attn_phase(char*lds,const AttnTensors&T,const Sched&S,int wave,const Hook&hook){
  AttnUnit u; const float nlam=*T.nlam;
  int lim_=4; asm volatile("":"+s"(lim_));
  for(int i=0;i<lim_&&S.next(i,u);++i){ hook(i); const int h=u.bh&7,b=u.bh>>3; attn_unit<THRL>(b,h,u.qb,T.Q,T.K,T.V,T.scat,T.lutg+h*LUTN,T.subg,nlam,lds,wave); }
  hook(4);
}
#undef SBAR
#undef WAIT_BAR
#undef LDSB8
}
constexpr int NWAVES = 8;
#ifndef MK_ONE_LAUNCH
#define MK_ONE_LAUNCH 1
#endif
constexpr int NPH = 12;

constexpr int M = 16384, D = 2048, SEQ = 4096, NB = 4;
constexpr int NE = 32, DE = 512, ECAP = 16384, PLE = 256;
constexpr float EPS = 1e-6f;

constexpr size_t MiB = 1u << 20;
constexpr size_t WS_CTL = 0, CTL_ZERO_BYTES = 32768;
constexpr size_t WS_R0 = 1 * MiB, WS_R2 = WS_R0 + 65536, WS_LUT = WS_R2 + 65536, WS_NLAM = WS_LUT + 16384 - 256, WS_SSC = WS_LUT + 16384;
constexpr size_t WS_SSQ1 = 2 * MiB, WS_SSQ3 = 4 * MiB, WS_RTS = 6 * MiB, WS_RW = 8 * MiB, WS_RR = 10 * MiB;
constexpr size_t WS_WIN = 12 * MiB, WS_WGLU = 28 * MiB, WS_WO = 30 * MiB, WS_WPG = 38 * MiB, WS_WPP = 46 * MiB, WS_WR = 47 * MiB, WS_W1T = 48 * MiB, WS_TVT = 56 * MiB, WS_W13 = 68 * MiB, WS_W2 = 132 * MiB, WS_X1F8 = 164 * MiB, WS_X2F8 = 196 * MiB;
constexpr size_t WS_A = 260 * MiB;
constexpr size_t WS_B = 324 * MiB;
constexpr size_t WS_B2 = WS_B + 64 * MiB;
constexpr size_t WS_PP = 452 * MiB, WS_PBF = 516 * MiB, WS_END = 524 * MiB;
constexpr int CW_TMO = 0, CW_CODE = 1, CW_CNT = 64;
constexpr int CW_BAR = 4096;

constexpr int RING_OFF = 0, RING_BYTES = 139264;
constexpr int LDSCTL_OFF = RING_BYTES, MISC_OFF = LDSCTL_OFF + 320;
constexpr int XTRA_OFF = RING_BYTES + 1024;
constexpr int LDS_BYTES = RING_BYTES + 1024 + 8192;
static_assert(XTRA_OFF + 8192 <= LDS_BYTES, "LDS map");

#define GAS __attribute__((address_space(1)))
#define LAS __attribute__((address_space(3)))
typedef unsigned short bf16;
typedef unsigned v4u __attribute__((ext_vector_type(4)));
typedef unsigned v2u __attribute__((ext_vector_type(2)));
typedef float f32x4 __attribute__((ext_vector_type(4)));
typedef short bf16x8 __attribute__((ext_vector_type(8)));
typedef float f32x16 __attribute__((ext_vector_type(16)));
typedef GAS unsigned gu32;
#define RLX_AGENT __ATOMIC_RELAXED, __HIP_MEMORY_SCOPE_AGENT
#define LDS_WAIT() asm volatile("s_waitcnt lgkmcnt(0)" ::: "memory")
#define VM_WAIT() asm volatile("s_waitcnt vmcnt(0)" ::: "memory")
__device__ __forceinline__ unsigned f2bf(float f) { unsigned u = __builtin_bit_cast(unsigned, f); return (u + 0x7fffu + ((u >> 16) & 1u)) >> 16; }
__device__ __forceinline__ unsigned pk2(float lo, float hi) { return f2bf(lo) | (f2bf(hi) << 16); }
__device__ __forceinline__ float bflo(unsigned w) { return __builtin_bit_cast(float, w << 16); }
__device__ __forceinline__ float bfhi(unsigned w) { return __builtin_bit_cast(float, w & 0xffff0000u); }

#define XB_TMO      128
#define XB_XCNT(j)  (256  + 64 * (j))
#define XB_XSUB(j)  (1280 + 64 * (j))
#define XB_XGEN(j)  (2304 + 64 * (j))
#define XB_TOP      3328
#define XB_TOPGEN   3392
#define XCD_BAR_WORDS 3456
#define XB_SPIN_CAP (1u << 18)

__device__ __forceinline__ unsigned xb_ld(unsigned* p)              { return __hip_atomic_load(p, __ATOMIC_RELAXED, __HIP_MEMORY_SCOPE_AGENT); }
__device__ __forceinline__ unsigned xb_add(unsigned* p, unsigned v) { return __hip_atomic_fetch_add(p, v, __ATOMIC_RELAXED, __HIP_MEMORY_SCOPE_AGENT); }
__device__ __forceinline__ unsigned xb_xcc_id() { return (unsigned)__builtin_amdgcn_s_getreg((3 << 11) | 20) & 0xFu; }
#define XB_SPIN(cond, bar) do { unsigned _sp = 0; while (cond) { __builtin_amdgcn_s_sleep(1); \
    if ((++_sp & 255u) == 0u) { if (xb_ld(&(bar)[XB_TMO])) break; if (_sp > XB_SPIN_CAP) { atomicAdd(&(bar)[XB_TMO], 1u); break; } } } } while (0)

struct XcdBarrier {
    unsigned* bar; unsigned x;
    volatile LAS unsigned* st;
};
__device__ __forceinline__ XcdBarrier xcd_barrier_post(unsigned* bar, volatile LAS unsigned* st, bool t0) {
    XcdBarrier b; b.bar = bar; b.x = xb_xcc_id(); b.st = st;
    if (t0) (void)xb_add(&bar[XB_XCNT(b.x)], 1u);
    return b;
}
__device__ __forceinline__ void xcd_barrier_complete(unsigned* bar, unsigned x, unsigned& nloc, unsigned& nx) {
    const unsigned G = gridDim.x * gridDim.y * gridDim.z;
    unsigned sum, cnt, mine, sp = 0u;
    for (;;) {
        sum = 0u; cnt = 0u; mine = 0u;
#pragma unroll
        for (unsigned j = 0; j < 16; ++j) { const unsigned c = xb_ld(&bar[XB_XCNT(j)]); sum += c; cnt += (c > 0u) ? 1u : 0u; mine = (j == x) ? c : mine; }
        if (sum == G) break;
        __builtin_amdgcn_s_sleep(1);
        if ((++sp & 255u) == 0u) { if (xb_ld(&bar[XB_TMO])) break; if (sp > XB_SPIN_CAP) { atomicAdd(&bar[XB_TMO], 1u); break; } }
    }
    nloc = mine > 0u ? mine : 1u; nx = cnt > 0u ? cnt : 1u;
}
__device__ __forceinline__ void xcd_barrier(const XcdBarrier& b, bool t0) {
    asm volatile("s_waitcnt vmcnt(0)" ::: "memory");
    __syncthreads();
    if (t0) {
        unsigned* bar = b.bar;
        __builtin_amdgcn_s_waitcnt(0);
        unsigned nloc = b.st[0], nx = b.st[1];
        if (nloc == 0u) { xcd_barrier_complete(bar, b.x, nloc, nx); b.st[0] = nloc; b.st[1] = nx; }
        const unsigned old = xb_add(&bar[XB_XSUB(b.x)], 1u);
        const unsigned gen = old / nloc;
        if (old + 1u == (gen + 1u) * nloc) {
            __builtin_amdgcn_fence(__ATOMIC_RELEASE, "agent");
            asm volatile("s_waitcnt vmcnt(0)" ::: "memory");
            const unsigned og = xb_add(&bar[XB_TOP], 1u);
            const unsigned tg = og / nx;
            if (og + 1u == (tg + 1u) * nx) xb_add(&bar[XB_TOPGEN], 1u);
            else XB_SPIN(xb_ld(&bar[XB_TOPGEN]) == tg, bar);
            __builtin_amdgcn_fence(__ATOMIC_ACQUIRE, "agent");
            xb_add(&bar[XB_XGEN(b.x)], 1u);
            asm volatile("s_waitcnt vmcnt(0)" ::: "memory");
        } else {
            XB_SPIN(xb_ld(&bar[XB_XGEN(b.x)]) == gen, bar);
            __builtin_amdgcn_fence(__ATOMIC_ACQUIRE, "agent");
            asm volatile("s_waitcnt vmcnt(0)" ::: "memory");
        }
    }
    __syncthreads();
}

struct Frame {
    LAS unsigned char* lds;
    volatile LAS unsigned* MISC;
    gu32* ctl;
    int wave;
    int vcu, G;
};
__device__ __forceinline__ int mk_lane() { int l; asm volatile("v_mbcnt_lo_u32_b32 %0, -1, 0\n\tv_mbcnt_hi_u32_b32 %0, -1, %0" : "=v"(l)); return l; }
#define MK_TID(F) ((F).wave * 64 + mk_lane())
__device__ __forceinline__ float wave_sum(float v) {
#pragma unroll
    for (int o = 1; o < 64; o <<= 1) v += __shfl_xor(v, o);
    return v;
}
struct TrItem { const float* W; const float* gk; bf16* WT; int N, ldk, k0, n0, drow0, dk0, f8; };
__device__ __forceinline__ void p0_tr_load(const TrItem& t, int lane, f32x4 (&v)[8]) {
#pragma unroll
    for (int i = 0; i < 8; ++i) v[i] = __builtin_nontemporal_load((const GAS f32x4*)(t.W + (size_t)(t.k0 + 8 * (lane >> 3) + i) * t.N + t.n0 + 4 * (lane & 7)));
}
__device__ __forceinline__ void p0_tr_store(const TrItem& t, const f32x4 (&v)[8], LAS float*, int lane) {
    const int a = lane >> 3, c = lane & 7; float g[8];
    const float sc = t.f8 ? 64.f : 1.f;
    if (t.gk) { const f32x4 g0 = *(const GAS f32x4*)(t.gk + t.k0 + 8 * a), g1 = *(const GAS f32x4*)(t.gk + t.k0 + 8 * a + 4);
        g[0] = g0.x * sc; g[1] = g0.y * sc; g[2] = g0.z * sc; g[3] = g0.w * sc; g[4] = g1.x * sc; g[5] = g1.y * sc; g[6] = g1.z * sc; g[7] = g1.w * sc; }
    else {
#pragma unroll
        for (int i = 0; i < 8; ++i) g[i] = sc; }
#pragma unroll
    for (int q = 0; q < 4; ++q) { float x[8];
#pragma unroll
        for (int i = 0; i < 8; ++i) x[i] = v[i][q] * g[i];
        const int n = 4 * c + q;
        if (t.f8) { v2u o; unsigned lo = 0, hi = 0;
            lo = __builtin_amdgcn_cvt_pk_fp8_f32(x[0], x[1], lo, false); lo = __builtin_amdgcn_cvt_pk_fp8_f32(x[2], x[3], lo, true);
            hi = __builtin_amdgcn_cvt_pk_fp8_f32(x[4], x[5], hi, false); hi = __builtin_amdgcn_cvt_pk_fp8_f32(x[6], x[7], hi, true); o.x = lo; o.y = hi;
            *(GAS v2u*)((unsigned char*)t.WT + (size_t)(t.drow0 + n) * t.ldk + t.dk0 + 8 * a) = o; }
        else { v4u o; o.x = pk2(x[0], x[1]); o.y = pk2(x[2], x[3]); o.z = pk2(x[4], x[5]); o.w = pk2(x[6], x[7]);
            *(GAS v4u*)(t.WT + (size_t)(t.drow0 + n) * t.ldk + t.dk0 + 8 * a) = o; } }
}

struct Ptrs {
    const float *x, *p, *rel_bias, *g_mix, *w_in, *lq1, *lk1, *lq2, *lk2, *subg, *s_lre, *s_lim, *s_ldt, *s_bre, *s_bim, *s_cre, *s_cim, *s_d, *w_glu, *b_glu, *g_ssm, *w_o, *g_ffn,
                *w_rg, *b_rg, *w_re, *b_re, *w1, *w3, *w2, *g_ple, *w_pg, *w_pp, *g_final;
    float* out; unsigned char* ws;
};

__device__ __forceinline__ void p0_ssm_group(const Frame& F, const Ptrs& P, int g, int qd) {
    LAS float* L = (LAS float*)(F.lds + RING_OFF);
    LAS float* pw = L;
    LAS float* bbr = L + 2304;
    LAS float* bbi = bbr + 1024;
    LAS float* cre = bbi + 1024;
    LAS float* cim = cre + 1024;
    LAS float* Kt = cim + 1024;
    LAS float* dd = Kt + 4096;
    const int tid = MK_TID(F);
    if (tid < 64) {
        const int p = tid;
        const float lre = P.s_lre[g * 64 + p], lim = P.s_lim[g * 64 + p], dt = expf(P.s_ldt[g]);
        const float mag = expf(lre * dt), ar = mag * cosf(lim * dt), ai = mag * sinf(lim * dt);
        const float den = lre * lre + lim * lim, nr = ar - 1.f, ni = ai;
        const float cr = (nr * lre + ni * lim) / den, ci = (ni * lre - nr * lim) / den;
        float gr = 1.f, gi = 0.f;
        for (int n = 0; n <= 16; ++n) { pw[(n * 64 + p) * 2] = gr; pw[(n * 64 + p) * 2 + 1] = gi; const float t = gr * ar - gi * ai; gi = gr * ai + gi * ar; gr = t; }
        float a16r = pw[(16 * 64 + p) * 2], a16i = pw[(16 * 64 + p) * 2 + 1], qr = a16r, qi = a16i;
        for (int s = 0; s < 5; ++s) { const float t = qr * qr - qi * qi; qi = 2.f * qr * qi; qr = t; }
        if (qd == 0) { float* sc = (float*)(P.ws + WS_SSC) + (g * 64 + p) * 4; sc[0] = a16r; sc[1] = a16i; sc[2] = qr; sc[3] = qi; }
        for (int h = 0; h < 16; ++h) { const float br = P.s_bre[(g * 64 + p) * 16 + h], bi = P.s_bim[(g * 64 + p) * 16 + h]; bbr[p * 16 + h] = cr * br - ci * bi; bbi[p * 16 + h] = cr * bi + ci * br; }
    }
    for (int i = tid; i < 1024; i += NWAVES * 64) { cre[i] = P.s_cre[g * 1024 + i]; cim[i] = P.s_cim[g * 1024 + i]; }
    if (tid < 16) dd[tid] = P.s_d[g * 16 + tid];
    __syncthreads();
    {
        const int h = (tid >> 4) & 15, h2 = tid & 15, t0 = tid >> 8; float acc[8];
#pragma unroll
        for (int k = 0; k < 8; ++k) acc[k] = 0.f;
        for (int p = 0; p < 64; ++p) { const float c1 = cre[h * 64 + p], c2 = cim[h * 64 + p], br = bbr[p * 16 + h2], bi = bbi[p * 16 + h2];
            const float X = c1 * br - c2 * bi, Y = c1 * bi + c2 * br;
#pragma unroll
            for (int k = 0; k < 8; ++k) { const int tau = t0 + 2 * k; acc[k] += pw[(tau * 64 + p) * 2] * X - pw[(tau * 64 + p) * 2 + 1] * Y; } }
#pragma unroll
        for (int k = 0; k < 8; ++k) Kt[((t0 + 2 * k) << 8) + (h << 4) + h2] = acc[k];
    }
    __syncthreads();
    bf16* TV = (bf16*)(P.ws + WS_TVT) + (size_t)g * 256 * 384;
    for (int it = tid; it < 64 * 48; it += NWAVES * 64) {
        const int n = 64 * qd + it / 48, k0 = (it % 48) * 8, i = n >> 4, h = n & 15; float v[8];
#pragma unroll
        for (int q = 0; q < 8; ++q) { const int k = k0 + q;
            if (k < 256) { const int j = k >> 4, h2 = k & 15; float t = (j <= i) ? Kt[((i - j) * 16 + h) * 16 + h2] : 0.f; if (j == i && h2 == h) t += dd[h]; v[q] = t; }
            else { const int p = (k - 256) & 63, part = (k - 256) >> 6; const float gr = pw[((i + 1) * 64 + p) * 2], gi = pw[((i + 1) * 64 + p) * 2 + 1], c1 = cre[h * 64 + p], c2 = cim[h * 64 + p];
                   v[q] = part == 0 ? (c1 * gr - c2 * gi) : (-c1 * gi - c2 * gr); } }
        v4u o; o.x = pk2(v[0], v[1]); o.y = pk2(v[2], v[3]); o.z = pk2(v[4], v[5]); o.w = pk2(v[6], v[7]);
        *(GAS v4u*)(TV + (size_t)n * 384 + k0) = o;
    }
    bf16* W1 = (bf16*)(P.ws + WS_W1T) + (size_t)g * 256 * 256;
    for (int it = tid; it < 64 * 32; it += NWAVES * 64) {
        const int n = 64 * qd + (it >> 5), k0 = (it & 31) * 8; float v[8];
#pragma unroll
        for (int q = 0; q < 8; ++q) { const int k = k0 + q, j = k >> 4, h2 = k & 15;
            if (n < 128) { const int p = n & 63; const float gr = pw[((15 - j) * 64 + p) * 2], gi = pw[((15 - j) * 64 + p) * 2 + 1], br = bbr[p * 16 + h2], bi = bbi[p * 16 + h2];
                           v[q] = n < 64 ? (gr * br - gi * bi) : (gr * bi + gi * br); }
            else v[q] = 0.f; }
        v4u o; o.x = pk2(v[0], v[1]); o.y = pk2(v[2], v[3]); o.z = pk2(v[4], v[5]); o.w = pk2(v[6], v[7]);
        *(GAS v4u*)(W1 + (size_t)n * 256 + k0) = o;
    }
    __syncthreads();
}

constexpr int P0_ITEMS_EARLY = 16 * 128 + 8 * 32;
constexpr int P0_ITEMS_ALL = 16 * 128 + 8 * 32 + 16 * 64 + 2 * NE * 16 * 16 + NE * 4 * 64 + 16 * 64 + 2 * 64;
__device__ __forceinline__ void p0_weights(const Frame& F, const Ptrs& P, int it0, int it1) {
    unsigned char* ws = P.ws;
    LAS float* scr = (LAS float*)(F.lds + RING_OFF + F.wave * 16384);
    const int gw = F.vcu * NWAVES + F.wave, NGW = F.G * NWAVES, lane = mk_lane();
    constexpr int I_IN = 16 * 128, I_GLU = 8 * 32, I_O = 16 * 64, I_13 = 2 * NE * 16 * 16, I_2 = NE * 4 * 64, I_PG = 16 * 64, I_PP = 2 * 64;
    constexpr int NITEMS = I_IN + I_GLU + I_O + I_13 + I_2 + I_PG + I_PP;
#define P0_DECODE(T, IT, HF) do { int r = (IT); T.f8 = 0; \
        if (r < I_IN) { const int kb = 2 * (r / 128) + (HF), nb = r % 128; T.W = P.w_in; T.N = 4096; T.gk = P.g_mix; T.WT = (bf16*)(ws + WS_WIN); T.ldk = 2048; T.k0 = 64 * kb; T.n0 = 32 * nb; T.drow0 = 32 * nb; T.dk0 = 64 * kb; break; } r -= I_IN; \
        if (r < I_GLU) { const int kb = 2 * (r / 32) + (HF), nb = r % 32; T.W = P.w_glu; T.N = 1024; T.gk = nullptr; T.WT = (bf16*)(ws + WS_WGLU); T.ldk = 1024; T.k0 = 64 * kb; T.n0 = 32 * nb; T.drow0 = 32 * nb; T.dk0 = 64 * kb; break; } r -= I_GLU; \
        if (r < I_O) { const int kb = 2 * (r / 64) + (HF), nb = r % 64; T.W = P.w_o; T.N = 2048; T.gk = (kb >= 16) ? (P.g_ssm - 1024) : nullptr; T.WT = (bf16*)(ws + WS_WO); T.ldk = 2048; T.k0 = 64 * kb; T.n0 = 32 * nb; T.drow0 = 32 * nb; T.dk0 = (64 * kb + 1024) & 2047; break; } r -= I_O; \
        if (r < I_13) { const int e = r / 512, q = r % 512, mat = q >> 8, kb = 2 * ((q & 255) / 16) + (HF), nb = q & 15, n0 = 32 * nb; T.W = (mat ? P.w3 : P.w1) + (size_t)e * 2048 * 512; T.N = 512; T.gk = P.g_ffn; \
            T.WT = (bf16*)(ws + WS_W13 + (size_t)e * 1024 * 2048); T.f8 = 1; T.ldk = 2048; T.k0 = 64 * kb; T.n0 = n0; T.drow0 = (n0 >> 7) * 256 + mat * 128 + (n0 & 127); T.dk0 = 64 * kb; break; } r -= I_13; \
        if (r < I_2) { const int e = r / 256, q = r % 256, kb = 2 * (q / 64) + (HF), nb = q % 64; T.W = P.w2 + (size_t)e * 512 * 2048; T.N = 2048; T.gk = nullptr; T.WT = (bf16*)(ws + WS_W2 + (size_t)e * 2048 * 512); T.f8 = 1; T.ldk = 512; \
            T.k0 = 64 * kb; T.n0 = 32 * nb; T.drow0 = 32 * nb; T.dk0 = 64 * kb; break; } r -= I_2; \
        if (r < I_PG) { const int kb = 2 * (r / 64) + (HF), nb = r % 64; T.W = P.w_pg; T.N = 2048; T.gk = P.g_ple; T.WT = (bf16*)(ws + WS_WPG); T.f8 = 1; T.ldk = 2048; T.k0 = 64 * kb; T.n0 = 32 * nb; T.drow0 = 32 * nb; T.dk0 = 64 * kb; break; } r -= I_PG; \
        { const int kb = 2 * (r / 64) + (HF), nb = r % 64; T.W = P.w_pp; T.N = 2048; T.gk = nullptr; T.WT = (bf16*)(ws + WS_WPP); T.ldk = 256; T.k0 = 64 * kb; T.n0 = 32 * nb; T.drow0 = 32 * nb; T.dk0 = 64 * kb; } } while (0)
    for (int it = it0 + gw; it < it1; it += NGW) {
        TrItem t0, t1; f32x4 v0[8], v1[8];
        P0_DECODE(t0, it, 0); p0_tr_load(t0, lane, v0);
        P0_DECODE(t1, it, 1); p0_tr_load(t1, lane, v1);
        p0_tr_store(t0, v0, scr, lane);
        p0_tr_store(t1, v1, scr, lane);
    }
#undef P0_DECODE
}
__device__ __forceinline__ void p0_prologue(const Frame& F, const Ptrs& P) {
    unsigned char* ws = P.ws;
    for (int gi = F.vcu; gi < 256; gi += F.G) p0_ssm_group(F, P, gi >> 2, gi & 3);
    const int gw = F.vcu * NWAVES + F.wave, NGW = F.G * NWAVES, lane = mk_lane();
    p0_weights(F, P, 0, P0_ITEMS_EARLY);
    for (int m = gw; m < M; m += 2 * NGW) {
        const int m1 = m + NGW;
        const GAS f32x4* xr = (const GAS f32x4*)(P.x + (size_t)m * D) + lane; const GAS f32x4* xr1 = (const GAS f32x4*)(P.x + (size_t)(m1 < M ? m1 : m) * D) + lane;
        f32x4 v[8], u[8]; float s = 0.f, s1 = 0.f;
#pragma unroll
        for (int j = 0; j < 8; ++j) { v[j] = __builtin_nontemporal_load(xr + 64 * j); u[j] = __builtin_nontemporal_load(xr1 + 64 * j); }
#pragma unroll
        for (int j = 0; j < 8; ++j) { s += (v[j].x * v[j].x + v[j].y * v[j].y) + (v[j].z * v[j].z + v[j].w * v[j].w); s1 += (u[j].x * u[j].x + u[j].y * u[j].y) + (u[j].z * u[j].z + u[j].w * u[j].w); }
        s = wave_sum(s); s1 = wave_sum(s1);
        if (lane == 0) { ((float*)(ws + WS_R0))[m] = 1.0f / sqrtf(s * (1.f / D) + EPS); if (m1 < M) ((float*)(ws + WS_R0))[m1] = 1.0f / sqrtf(s1 * (1.f / D) + EPS); }
        GAS v2u* o8 = (GAS v2u*)((bf16*)(ws + WS_A) + (size_t)m * D) + lane;
#pragma unroll
        for (int j = 0; j < 8; ++j) { v2u o; o.x = pk2(v[j].x, v[j].y); o.y = pk2(v[j].z, v[j].w); o8[64 * j] = o; }
        if (m1 < M) { GAS v2u* o9 = (GAS v2u*)((bf16*)(ws + WS_A) + (size_t)m1 * D) + lane;
#pragma unroll
            for (int j = 0; j < 8; ++j) { v2u o; o.x = pk2(u[j].x, u[j].y); o.y = pk2(u[j].z, u[j].w); o9[64 * j] = o; } }
    }
    { const int gt = (F.vcu * NWAVES + F.wave) * 64 + lane, NT = F.G * NWAVES * 64;
      for (int i = gt; i < M * PLE / 4; i += 4 * NT) { f32x4 v[4];
#pragma unroll
          for (int q = 0; q < 4; ++q) { const int ii = i + q * NT; v[q] = ((const GAS f32x4*)P.p)[ii < M * PLE / 4 ? ii : i]; }
#pragma unroll
          for (int q = 0; q < 4; ++q) { const int ii = i + q * NT; if (ii < M * PLE / 4) { v2u o; o.x = pk2(v[q].x, v[q].y); o.y = pk2(v[q].z, v[q].w); ((GAS v2u*)(ws + WS_PBF))[ii] = o; } } }
      for (int i = gt; i < 64 * 2048; i += NT) { const int j = i >> 11, k = i & 2047; float v = 0.f;
          if (j < 4) v = P.w_rg[k * 4 + j] * P.g_ffn[k]; else if (j < 36) v = P.w_re[k * 32 + (j - 4)] * P.g_ffn[k];
          ((bf16*)(ws + WS_WR))[i] = (bf16)f2bf(v); }
      if (gt < 64) { const float lam = __expf(wave_sum(P.lq1[lane] * P.lk1[lane])) - __expf(wave_sum(P.lq2[lane] * P.lk2[lane])) + 0.2f; if (gt == 0) *(float*)(ws + WS_NLAM) = -lam; }
      for (int i = gt; i < 8 * 384; i += NT) { const int h = i / 384, n = i % 384 - 127; int bucket = 31;
          if (n >= 0 && n < 16) bucket = n; else if (n >= 16 && n < 128) { const int lg = 16 + (int)(logf((float)n / 16.f) / 2.0794415416798357f * 16.f); bucket = lg < 31 ? lg : 31; }
          ((float*)(ws + WS_LUT))[i] = (P.rel_bias[bucket * 8 + h] - P.rel_bias[31 * 8 + h]) * 1.4426950408889634f; }
    }
}

__device__ __forceinline__ void ssm_scan(const Frame& F, const Ptrs& P, int g, bf16* item) {
    const LAS float* E = (const LAS float*)(F.lds + RING_OFF);
    LAS float* S = (LAS float*)(F.lds + XTRA_OFF);
    const int p = mk_lane(), w = F.wave, c0 = 32 * w;
    const f32x4 sc = *(const f32x4*)((const float*)(P.ws + WS_SSC) + (g * 64 + p) * 4);
    float xr = 0.f, xi = 0.f;
#pragma unroll 8
    for (int c = c0; c < c0 + 32; ++c) { const float er = E[c * 128 + p], ei = E[c * 128 + 64 + p]; const float t = sc.x * xr - sc.y * xi + er; xi = sc.x * xi + sc.y * xr + ei; xr = t; }
    S[(w * 64 + p) * 2] = xr; S[(w * 64 + p) * 2 + 1] = xi;
    __syncthreads();
    xr = 0.f; xi = 0.f;
    for (int w2 = 0; w2 < w; ++w2) { const float t = sc.z * xr - sc.w * xi + S[(w2 * 64 + p) * 2]; xi = sc.z * xi + sc.w * xr + S[(w2 * 64 + p) * 2 + 1]; xr = t; }
#pragma unroll 8
    for (int c = c0; c < c0 + 32; ++c) {
        bf16* row = item + (size_t)c * 384 + 256; row[p] = (bf16)f2bf(xr); row[64 + p] = (bf16)f2bf(xi);
        const float er = E[c * 128 + p], ei = E[c * 128 + 64 + p]; const float t = sc.x * xr - sc.y * xi + er; xi = sc.x * xi + sc.y * xr + ei; xr = t; }
    VM_WAIT(); __syncthreads();
}
struct OneUnit { pg8::Unit u; __device__ __forceinline__ bool next(int i, pg8::Unit& o) const { if (i > 0) return false; o = u; return true; } };

__device__ __forceinline__ void p6_router(const Frame& F, const Ptrs& P) {
    const int lane = mk_lane(), w = F.wave, th = w & 1, kq = w >> 1, r32 = lane & 31, hi = lane >> 5, rtid = w * 64 + lane;
    const bf16* x1b = (const bf16*)(P.ws + WS_A); const bf16* WrT = (const bf16*)(P.ws + WS_WR);
    LAS float* red = (LAS float*)(F.lds + RING_OFF);
    LAS int* lcnt = (LAS int*)(F.lds + XTRA_OFF);
    int* cnt = (int*)(F.ctl + CW_CNT);
    int* row_ts = (int*)(P.ws + WS_RTS); float* row_w = (float*)(P.ws + WS_RW); float* row_r = (float*)(P.ws + WS_RR);
    const float* ssq1 = (const float*)(P.ws + WS_SSQ1);
    for (int blk = F.vcu; blk < M / 64; blk += F.G) {
        const int T0 = blk * 64;
        if (rtid < 64) lcnt[rtid] = 0;
        f32x16 acc0 = {}, acc1 = {};
        const bf16* ap = x1b + (size_t)(T0 + 32 * th + r32) * 2048 + kq * 512 + 8 * hi;
        const bf16* bp0 = WrT + (size_t)r32 * 2048 + kq * 512 + 8 * hi; const bf16* bp1 = bp0 + 32 * 2048;
#pragma unroll 4
        for (int ks = 0; ks < 32; ++ks) {
            const bf16x8 a = *(const GAS bf16x8*)(ap + ks * 16), b0 = *(const GAS bf16x8*)(bp0 + ks * 16), b1 = *(const GAS bf16x8*)(bp1 + ks * 16);
            acc0 = __builtin_amdgcn_mfma_f32_32x32x16_bf16(a, b0, acc0, 0, 0, 0); acc1 = __builtin_amdgcn_mfma_f32_32x32x16_bf16(a, b1, acc1, 0, 0, 0);
        }
#pragma unroll
        for (int r = 0; r < 16; ++r) { const int tk = 32 * th + (r & 3) + 8 * (r >> 2) + 4 * hi; red[(kq * 64 + tk) * 64 + r32] = acc0[r]; red[(kq * 64 + tk) * 64 + 32 + r32] = acc1[r]; }
        __syncthreads();
        int e0 = 0, e1 = 0, lp0 = 0, lp1 = 0; float w0 = 0.f, w1 = 0.f, r1 = 0.f;
        if (rtid < 64) {
            const int tok = T0 + rtid; float ss = 0.f;
            for (int i = 0; i < 32; ++i) ss += ssq1[(size_t)tok * 32 + i];
            r1 = 1.0f / sqrtf(ss * (1.f / D) + EPS);
            float lg[4];
#pragma unroll
            for (int j = 0; j < 4; ++j) lg[j] = (red[(0 * 64 + rtid) * 64 + j] + red[(1 * 64 + rtid) * 64 + j] + red[(2 * 64 + rtid) * 64 + j] + red[(3 * 64 + rtid) * 64 + j]) * r1 + P.b_rg[j];
            int gs = 0; float lm = lg[0];
            if (lg[1] > lm) { lm = lg[1]; gs = 1; } if (lg[2] > lm) { lm = lg[2]; gs = 2; } if (lg[3] > lm) { lm = lg[3]; gs = 3; }
            const float gate_g = 1.0f / (__expf(lg[0] - lm) + __expf(lg[1] - lm) + __expf(lg[2] - lm) + __expf(lg[3] - lm));
            float m0 = -3.0e38f, m1 = -3.0e38f; int i0 = 0, i1 = 0;
            for (int j = 0; j < 8; ++j) { const int c = 4 + gs * 8 + j;
                const float le = (red[(0 * 64 + rtid) * 64 + c] + red[(1 * 64 + rtid) * 64 + c] + red[(2 * 64 + rtid) * 64 + c] + red[(3 * 64 + rtid) * 64 + c]) * r1 + P.b_re[gs * 8 + j];
                if (le > m0) { m1 = m0; i1 = i0; m0 = le; i0 = j; } else if (le > m1) { m1 = le; i1 = j; } }
            const float p1 = __expf(m1 - m0);
            w0 = gate_g / (1.f + p1); w1 = gate_g * p1 / (1.f + p1); e0 = gs * 8 + i0; e1 = gs * 8 + i1;
            lp0 = atomicAdd((int*)&lcnt[e0], 1); lp1 = atomicAdd((int*)&lcnt[e1], 1);
        }
        __syncthreads();
        if (rtid < 32) { const int n = lcnt[rtid]; lcnt[32 + rtid] = n ? atomicAdd(&cnt[rtid], n) : 0; }
        __syncthreads();
        if (rtid < 64) { const int tok = T0 + rtid;
            const int i0 = e0 * ECAP + lcnt[32 + e0] + lp0, i1 = e1 * ECAP + lcnt[32 + e1] + lp1;
            row_ts[i0] = tok * 2; row_w[i0] = w0; row_r[i0] = r1; row_ts[i1] = tok * 2 + 1; row_w[i1] = w1; row_r[i1] = r1; }
        __syncthreads();
    }
}

template <int NTN, bool UP>
struct MoeOrder {
    const LAS int* pre;
    const char* A; const char* B; const int* row_ts; const int* cnt; int G, c;
    __device__ __forceinline__ bool next(int i, pg8::Unit& u) const {
        const int L = i * G + c, TT = pre[32]; if (L >= TT * NTN) return false;
        const int ti = L / NTN, nt = L % NTN; int e = 0;
        for (int q = 1; q < 32; ++q) e += (ti >= pre[q]) ? 1 : 0;
        const int mt = ti - pre[e];
        u.pm = ti; u.pn = nt; u.x0 = e * ECAP + mt * 256;
        if (UP) { u.A = A; u.B = B + ((size_t)e * 1024 + (size_t)nt * 256) * 2048; u.rows = row_ts + u.x0; u.x1 = ti; }
        else { u.A = A + (size_t)ti * 256 * 512; u.B = B + ((size_t)e * 2048 + (size_t)nt * 256) * 512; u.rows = nullptr; const int left = cnt[e] - mt * 256; u.x1 = left < 256 ? left : 256; }
        if (UP) { const int left = cnt[e] - mt * 256; u.pn = nt; u.pm = left < 256 ? left : 256; }
        return true;
    }
    __device__ __forceinline__ int arow(const pg8::Unit& u, int r) const { if (!UP) return r; return r < u.pm ? (u.rows[r] >> 1) : 0; }
};
__device__ __forceinline__ void moe_prefix(const Frame& F) {
    LAS int* pre = (LAS int*)(F.lds + XTRA_OFF + 1024);
    __syncthreads();
    if (MK_TID(F) == 0) { int s = 0; for (int e = 0; e < 32; ++e) { pre[e] = s; s += ((int)__hip_atomic_load(F.ctl + CW_CNT + e, RLX_AGENT) + 255) >> 8; } pre[32] = s; }
    __syncthreads();
}

__device__ __forceinline__ void p9_combine(const Frame& F, const Ptrs& P) {
    const int lane = mk_lane(), gw = F.vcu * NWAVES + F.wave, NGW = F.G * NWAVES;
    const bf16* x1b = (const bf16*)(P.ws + WS_A); const unsigned char* c0 = (const unsigned char*)P.out; const unsigned char* c1 = c0 + (size_t)M * 2048; bf16* x2b = (bf16*)(P.ws + WS_B); unsigned char* x2f8 = P.ws + WS_X2F8;
    for (int m = gw; m < M; m += NGW) { float q = 0.f; v4u o[4]; v2u o8[4];
#pragma unroll
        for (int j = 0; j < 4; ++j) { const size_t off = (size_t)m * 2048 + (size_t)(j * 64 + lane) * 8;
            const v4u a = __builtin_nontemporal_load((const GAS v4u*)(x1b + off)); const v2u b = __builtin_nontemporal_load((const GAS v2u*)(c0 + off)), c = __builtin_nontemporal_load((const GAS v2u*)(c1 + off));
            float f[8];
#pragma unroll
            for (int i = 0; i < 4; ++i) { const unsigned bw = (i < 2) ? b.x : b.y, cw = (i < 2) ? c.x : c.y;
                const pg8::f32x2 bb = (i & 1) ? __builtin_amdgcn_cvt_pk_f32_fp8(bw, true) : __builtin_amdgcn_cvt_pk_f32_fp8(bw, false), cc = (i & 1) ? __builtin_amdgcn_cvt_pk_f32_fp8(cw, true) : __builtin_amdgcn_cvt_pk_f32_fp8(cw, false);
                const float lo = bflo(a[i]) + (bb[0] + cc[0]) * 0.03125f, hi = bfhi(a[i]) + (bb[1] + cc[1]) * 0.03125f; q += lo * lo + hi * hi; o[j][i] = pk2(lo, hi); f[2 * i] = lo; f[2 * i + 1] = hi; }
            { unsigned w0 = 0, w1 = 0; w0 = __builtin_amdgcn_cvt_pk_fp8_f32(f[0], f[1], w0, false); w0 = __builtin_amdgcn_cvt_pk_fp8_f32(f[2], f[3], w0, true);
              w1 = __builtin_amdgcn_cvt_pk_fp8_f32(f[4], f[5], w1, false); w1 = __builtin_amdgcn_cvt_pk_fp8_f32(f[6], f[7], w1, true); o8[j].x = w0; o8[j].y = w1; } }
        q = wave_sum(q);
        if (lane == 0) ((float*)(P.ws + WS_R2))[m] = 1.0f / sqrtf(q * (1.f / D) + EPS);
#pragma unroll
        for (int j = 0; j < 4; ++j) { *(GAS v4u*)(x2b + (size_t)m * 2048 + (size_t)(j * 64 + lane) * 8) = o[j]; *(GAS v2u*)(x2f8 + (size_t)m * 2048 + (size_t)(j * 64 + lane) * 8) = o8[j]; }
    }
}
__device__ __forceinline__ void p11_final(const Frame& F, const Ptrs& P) {
    const int lane = mk_lane(), gw = F.vcu * NWAVES + F.wave, NGW = F.G * NWAVES;
    const bf16* x3b = (const bf16*)(P.ws + WS_B2); const float* ssq3 = (const float*)(P.ws + WS_SSQ3);
    for (int m = gw; m < M; m += NGW) {
        const float r3 = 1.0f / sqrtf(wave_sum(lane < 32 ? ssq3[(size_t)m * 32 + lane] : 0.f) * (1.f / D) + EPS);
#pragma unroll
        for (int j = 0; j < 4; ++j) { const size_t col = (size_t)(j * 64 + lane) * 8; const v4u a = __builtin_nontemporal_load((const GAS v4u*)(x3b + (size_t)m * 2048 + col));
            const f32x4 g0 = *(const GAS f32x4*)(P.g_final + col), g1 = *(const GAS f32x4*)(P.g_final + col + 4);
            f32x4 o0, o1; o0.x = bflo(a.x) * r3 * g0.x; o0.y = bfhi(a.x) * r3 * g0.y; o0.z = bflo(a.y) * r3 * g0.z; o0.w = bfhi(a.y) * r3 * g0.w;
            o1.x = bflo(a.z) * r3 * g1.x; o1.y = bfhi(a.z) * r3 * g1.y; o1.z = bflo(a.w) * r3 * g1.z; o1.w = bfhi(a.w) * r3 * g1.w;
            *(GAS f32x4*)(P.out + (size_t)m * 2048 + col) = o0; *(GAS f32x4*)(P.out + (size_t)m * 2048 + col + 4) = o1; }
    }
}

struct Args { const float* in[34]; float* out; unsigned char* ws; int ph_lo, ph_hi, li, pad; };
__global__ void __launch_bounds__(NWAVES * 64, 2) mk_fwd(Args args) {
    extern __shared__ __attribute__((aligned(16))) unsigned char lds[];
    Frame F;
    F.lds = (LAS unsigned char*)lds;
    F.MISC = (volatile LAS unsigned*)(F.lds + MISC_OFF);
    F.wave = __builtin_amdgcn_readfirstlane((int)threadIdx.x >> 6);
    F.G = gridDim.x; { const int bx = blockIdx.x; F.vcu = (F.G % 8 == 0) ? (bx % 8) * (F.G / 8) + bx / 8 : bx; }
    Ptrs P;
    P.x = args.in[0]; P.p = args.in[1]; P.rel_bias = args.in[2]; P.g_mix = args.in[3]; P.w_in = args.in[4]; P.lq1 = args.in[5]; P.lk1 = args.in[6]; P.lq2 = args.in[7]; P.lk2 = args.in[8]; P.subg = args.in[9];
    P.s_lre = args.in[10]; P.s_lim = args.in[11]; P.s_ldt = args.in[12]; P.s_bre = args.in[13]; P.s_bim = args.in[14]; P.s_cre = args.in[15]; P.s_cim = args.in[16]; P.s_d = args.in[17];
    P.w_glu = args.in[18]; P.b_glu = args.in[19]; P.g_ssm = args.in[20]; P.w_o = args.in[21]; P.g_ffn = args.in[22]; P.w_rg = args.in[23]; P.b_rg = args.in[24]; P.w_re = args.in[25]; P.b_re = args.in[26];
    P.w1 = args.in[27]; P.w3 = args.in[28]; P.w2 = args.in[29]; P.g_ple = args.in[30]; P.w_pg = args.in[31]; P.w_pp = args.in[32]; P.g_final = args.in[33];
    P.out = args.out; P.ws = args.ws;
    unsigned char* ws = args.ws;
    F.ctl = (gu32*)(ws + WS_CTL);
    for (int u = MK_TID(F); u < (LDS_BYTES - LDSCTL_OFF) / 4; u += NWAVES * 64) ((LAS unsigned*)(F.lds + LDSCTL_OFF))[u] = 0u;
    __syncthreads();
    XcdBarrier bar; bar.bar = (unsigned*)(F.ctl + CW_BAR); bar.x = 0; bar.st = nullptr;
    if (MK_ONE_LAUNCH) bar = xcd_barrier_post((unsigned*)(F.ctl + CW_BAR), F.MISC + 8, MK_TID(F) == 0);
#define GRID_BAR() do { if (MK_ONE_LAUNCH) xcd_barrier(bar, MK_TID(F) == 0); } while (0)
    const int lo = args.ph_lo, hi = args.ph_hi;
#ifndef ONLY_PH
#define ONLY_PH -1
#endif
#define IN(k) ((ONLY_PH == -1 || ONLY_PH == (k)) && lo <= (k) && (k) < hi)
#define BOTH(k) (IN(k) && IN((k) + 1))
    bf16* Qb = (bf16*)P.out; bf16* Kb = Qb + (size_t)M * 1024; bf16* Vb = Kb + (size_t)M * 1024; bf16* s1b = Vb + (size_t)M * 1024;
    bf16* Ue = (bf16*)(ws + WS_B);

    if (IN(0)) { p0_prologue(F, P); if (BOTH(0)) GRID_BAR(); }

    if (IN(1)) {
        pg8::DenseOrder S; S.init(ws + WS_A, ws + WS_WIN, 2048, 2048, M, 4096, F.G, (int)blockIdx.x);
        pg8::EpiZ E; E.Q = Qb; E.Ue = Ue; E.r0 = (const float*)(ws + WS_R0); E.c2 = attn_body::C2;
        pg8::gemm_phase<pg8::EpiZ, pg8::DenseOrder, true, false>(F.lds + RING_OFF, F.wave, 2048, 2048, 2048, S, E);
        if (BOTH(1)) GRID_BAR();
    }
    if (IN(2)) {
#ifndef SKIP_SSM
        for (int item = F.vcu; item < 256; item += F.G) {
            const int g = item >> 2, b = item & 3;
            bf16* itA = Ue + (size_t)item * 256 * 384;
            OneUnit S1; S1.u.A = (const char*)itA; S1.u.B = (const char*)((bf16*)(ws + WS_W1T) + (size_t)g * 256 * 256); S1.u.rows = nullptr; S1.u.pm = 0; S1.u.pn = 0; S1.u.x0 = g; S1.u.x1 = b;
            pg8::EpiE E1;
            pg8::gemm_phase<pg8::EpiE, OneUnit, false, false>(F.lds + RING_OFF, F.wave, 256, 384, 256, S1, E1);
            __syncthreads();
            ssm_scan(F, P, g, itA);
            OneUnit S2; S2.u = S1.u; S2.u.B = (const char*)((bf16*)(ws + WS_TVT) + (size_t)g * 256 * 384);
            pg8::EpiY E2; E2.s1 = s1b;
            pg8::gemm_phase<pg8::EpiY, OneUnit, false, false>(F.lds + RING_OFF, F.wave, 384, 384, 384, S2, E2);
            __syncthreads();
        }
#endif
#ifndef SKIP_ATTN
        const attn_body::AttnTensors AT{(const attn_body::bf16*)Qb, (const attn_body::bf16*)Kb, (const attn_body::bf16*)Vb, (attn_body::bf16*)(ws + WS_B2), (const float*)(ws + WS_LUT), P.subg, (const float*)(ws + WS_NLAM)};
        const attn_body::StaticOrder S((int)F.G, (int)blockIdx.x);
        const int cpos = (F.vcu & 3) == 0 ? 0 : (F.vcu & 3) + 1;
        auto hook = [&](int i) { if (i == cpos) { p0_weights(F, P, P0_ITEMS_EARLY, P0_ITEMS_ALL); asm volatile("s_waitcnt vmcnt(0) lgkmcnt(0)" ::: "memory"); __syncthreads(); } };
        attn_body::attn_phase<attn_body::StaticOrder>((char*)lds + RING_OFF, AT, S, F.wave, hook);
#endif
        if (BOTH(2)) GRID_BAR();
    }
    if (IN(3)) {
        pg8::DenseOrder S; S.init(s1b, ws + WS_WGLU, 1024, 1024, M, 1024, F.G, (int)blockIdx.x);
        pg8::EpiGlu E; E.s1 = s1b; E.bias = P.b_glu; E.scat = (bf16*)(ws + WS_B2); E.ssq = (float*)(ws + WS_SSQ3);
        pg8::gemm_phase<pg8::EpiGlu, pg8::DenseOrder, true, false>(F.lds + RING_OFF, F.wave, 1024, 1024, 1024, S, E);
        if (IN(3) && IN(5)) GRID_BAR();
    }
    if (IN(5)) {
        pg8::DenseOrder S; S.init(ws + WS_B2, ws + WS_WO, 2048, 2048, M, 2048, F.G, (int)blockIdx.x);
        LAS float* rsT = (LAS float*)(F.lds + XTRA_OFF);
        { const int tid = MK_TID(F); const float* sp = (const float*)(ws + WS_SSQ3);
          for (int k = tid >> 8; k < 8; k += 2) { pg8::Unit u; if (!S.next(k, u)) break;
              const f32x4* q4 = (const f32x4*)(sp + (size_t)(u.pm * 256 + (tid & 255)) * 16); const f32x4 a = q4[0], b = q4[1], c = q4[2], d = q4[3];
              const float ss = ((a.x + a.y) + (a.z + a.w)) + ((b.x + b.y) + (b.z + b.w)) + ((c.x + c.y) + (c.z + c.w)) + ((d.x + d.y) + (d.z + d.w));
              rsT[k * 256 + (tid & 255)] = 1.0f / sqrtf(ss * (1.f / 1024.f) + EPS); }
          __syncthreads(); }
        pg8::EpiRes1 E; E.x = P.x; E.x1b = (bf16*)(ws + WS_A); E.x1f8 = ws + WS_X1F8; E.ssq = (float*)(ws + WS_SSQ1); E.rsT = rsT;
        pg8::gemm_phase<pg8::EpiRes1, pg8::DenseOrder, true, false>(F.lds + RING_OFF, F.wave, 2048, 2048, 2048, S, E);
        if (BOTH(5)) GRID_BAR();
    }
    if (IN(6)) {
        p6_router(F, P);
        if (BOTH(6)) GRID_BAR();
    }
    if (IN(7)) {
        moe_prefix(F);
        MoeOrder<4, true> S; S.pre = (const LAS int*)(F.lds + XTRA_OFF + 1024); S.A = (const char*)(ws + WS_X1F8); S.B = (const char*)(ws + WS_W13); S.row_ts = (const int*)(ws + WS_RTS); S.cnt = (const int*)(F.ctl + CW_CNT); S.G = F.G; S.c = F.vcu;
        pg8::EpiUp E; E.row_r = (const float*)(ws + WS_RR); E.hmid = ws + WS_B2;
        pg8::gemm_phase<pg8::EpiUp, MoeOrder<4, true>, true, true, true>(F.lds + RING_OFF, F.wave, 2048, 2048, 2048, S, E);
        {
          const int NU = S.pre[32] * 4, Rr = (NU + F.G - 1) / F.G, first_short = NU - (Rr - 1) * F.G; int Gp = F.G - first_short, rank = F.vcu - first_short;
          if (NU == 0 || Gp < 64) { Gp = F.G; rank = F.vcu; }
          if (rank >= 0) { pg8::DenseOrder Sp; Sp.init(ws + WS_PBF, ws + WS_WPP, 256, 256, M, 2048, Gp, rank);
              pg8::EpiPP Ep; Ep.pp = ws + WS_PP;
              pg8::gemm_phase<pg8::EpiPP, pg8::DenseOrder, true, false>(F.lds + RING_OFF, F.wave, 256, 256, 256, Sp, Ep); } }
        if (BOTH(7)) GRID_BAR();
    }
    if (IN(8)) {
        moe_prefix(F);
        MoeOrder<8, false> S; S.pre = (const LAS int*)(F.lds + XTRA_OFF + 1024); S.A = (const char*)(ws + WS_B2); S.B = (const char*)(ws + WS_W2); S.row_ts = (const int*)(ws + WS_RTS); S.cnt = (const int*)(F.ctl + CW_CNT); S.G = F.G; S.c = F.vcu;
        pg8::EpiDown E; E.row_ts = (const int*)(ws + WS_RTS); E.row_w = (const float*)(ws + WS_RW); E.contrib = (unsigned char*)P.out;
        pg8::gemm_phase<pg8::EpiDown, MoeOrder<8, false>, true, true, true>(F.lds + RING_OFF, F.wave, 512, 512, 512, S, E);
        if (BOTH(8)) GRID_BAR();
    }
    if (IN(9)) { p9_combine(F, P); if (BOTH(9)) GRID_BAR(); }
    if (IN(10)) {
        pg8::DenseOrder S; S.init(ws + WS_X2F8, ws + WS_WPG, 1024, 1024, M, 2048, F.G, (int)blockIdx.x);
        pg8::EpiGate E; E.x2b = (const bf16*)(ws + WS_B); E.pp = (const unsigned char*)(ws + WS_PP); E.r2 = (const float*)(ws + WS_R2); E.x3b = (bf16*)(ws + WS_B2); E.ssq = (float*)(ws + WS_SSQ3);
        pg8::gemm_phase<pg8::EpiGate, pg8::DenseOrder, true, true, true>(F.lds + RING_OFF, F.wave, 2048, 2048, 2048, S, E);
        if (BOTH(10)) GRID_BAR();
    }
    if (IN(11)) { p11_final(F, P); }
#undef IN
#undef BOTH
}

extern "C" void kernel_launch(void* const* d_in, const int* in_sizes, int n_in, void* d_out, int out_size, void* d_ws, size_t ws_size, hipStream_t stream) {
    static int grid = 0;
    if (grid == 0) {
        if (n_in != 34 || out_size != M * D || ws_size < WS_END) { fprintf(stderr, "kernel_launch: unexpected shapes (n_in %d, out %d, ws %zu); nothing launched\n", n_in, out_size, ws_size); grid = -1; return; }
        int dev = 0, cus = 0, per_cu = 0;
        if (hipGetDevice(&dev) != hipSuccess || hipDeviceGetAttribute(&cus, hipDeviceAttributeMultiprocessorCount, dev) != hipSuccess) { grid = -1; return; }
        if (hipFuncSetAttribute((const void*)mk_fwd, hipFuncAttributeMaxDynamicSharedMemorySize, LDS_BYTES) != hipSuccess) { fprintf(stderr, "kernel_launch: hipFuncSetAttribute failed\n"); grid = -1; return; }
        if (hipOccupancyMaxActiveBlocksPerMultiprocessor(&per_cu, (const void*)mk_fwd, NWAVES * 64, LDS_BYTES) != hipSuccess || per_cu < 1) { fprintf(stderr, "kernel_launch: occupancy query reports %d\n", per_cu); per_cu = 1; }
        (void)hipGetLastError();
        grid = cus;
    }
    if (grid < 0) return;
    if (hipMemsetAsync((char*)d_ws + WS_CTL, 0, CTL_ZERO_BYTES, stream) != hipSuccess) return;
    Args a{};
    for (int i = 0; i < 34; ++i) a.in[i] = (const float*)d_in[i];
    a.out = (float*)d_out; a.ws = (unsigned char*)d_ws; a.pad = 0;
    if (MK_ONE_LAUNCH) { a.ph_lo = 0; a.ph_hi = NPH; a.li = 0; hipLaunchKernelGGL(mk_fwd, dim3(grid), dim3(NWAVES * 64), LDS_BYTES, stream, a); }
    else for (int li = 0; li < NPH; ++li) { a.ph_lo = li; a.ph_hi = li + 1; a.li = li; hipLaunchKernelGGL(mk_fwd, dim3(grid), dim3(NWAVES * 64), LDS_BYTES, stream, a); }
}
```

```cpp
#include <hip/hip_runtime.h>
#include <hip/hip_bf16.h>
#include <cstdio>
#include <cstdint>
#include <cmath>
namespace pg8 {
#define PG8_LAS __attribute__((address_space(3)))
typedef unsigned short bf16_t;
typedef short bf16x8 __attribute__((ext_vector_type(8)));
typedef float f32x4 __attribute__((ext_vector_type(4)));
typedef float f32x2 __attribute__((ext_vector_type(2)));
typedef unsigned u32x4 __attribute__((ext_vector_type(4)));
typedef int v4i __attribute__((ext_vector_type(4)));
typedef int v8i __attribute__((ext_vector_type(8)));
constexpr int BM = 256, BK = 64, HALF = 128, HTB = HALF * BK * 2  , STAGE_BYTES = 8 * HTB, NXCD = 8, WGM = 8;

__host__ __device__ __forceinline__ int lds_byte(int r, int c) { const int st = (r >> 4) * 2 + (c >> 5), rr = r & 15, cc = c & 31, ob = rr * 64 + cc * 2; return st * 1024 + (ob ^ (((ob >> 9) & 1) << 5)); }
__host__ __device__ __forceinline__ void stage_rc(int b, int& R, int& C) { const int st = b / 1024, sb = b % 1024, swz = sb ^ (((sb >> 9) & 1) << 5); R = (st >> 1) * 16 + swz / 64; C = (st & 1) * 32 + (swz % 64) / 2; }
__host__ __device__ __forceinline__ int perm32(int rho) { const int n = rho >> 4, i = rho & 15; return 8 * (i >> 2) + 4 * n + (i & 3); }

struct Unit { const char* A; const char* B; const int* rows; int pm, pn, x0, x1; };

struct DenseOrder {
    const char* A; const char* Bt; int lda2, ldb2  , nM, nN, nwg, G, c;
    __device__ __forceinline__ void init(const void* A_, const void* Bt_, int lda, int ldb, int M, int N, int G_, int c_) { A = (const char*)A_; Bt = (const char*)Bt_; lda2 = lda * 2; ldb2 = ldb * 2; nM = M / BM; nN = N / BM; nwg = nM * nN; G = G_; c = c_; }
    __device__ __forceinline__ bool next(int i, Unit& u) const {
        const long L = (long)i * G + c; if (L >= nwg) return false;
        int wgid = (int)L; { const int q = nwg / NXCD, r = nwg % NXCD, xcd = wgid % NXCD, off = wgid / NXCD; wgid = (xcd < r ? xcd * (q + 1) : r * (q + 1) + (xcd - r) * q) + off; }
        const int nig = WGM * nN, gid = wgid / nig, fm = gid * WGM, gsz = (nM - fm) < WGM ? (nM - fm) : WGM;
        u.pm = fm + ((wgid % nig) % gsz); u.pn = (wgid % nig) / gsz;
        u.A = A + (size_t)u.pm * BM * lda2; u.B = Bt + (size_t)u.pn * BM * ldb2; u.rows = nullptr; u.x0 = i; u.x1 = 0; return true;
    }
    __device__ __forceinline__ int arow(const Unit&, int r) const { return r; }
};

__device__ __forceinline__ unsigned cvt_pk_bf16(float lo, float hi) { unsigned r; asm volatile("v_cvt_pk_bf16_f32 %0, %1, %2" : "=v"(r) : "v"(lo), "v"(hi)); return r; }
__device__ __forceinline__ float bf_lo(unsigned w) { return __builtin_bit_cast(float, w << 16); }
__device__ __forceinline__ float bf_hi(unsigned w) { return __builtin_bit_cast(float, w & 0xffff0000u); }
__device__ __forceinline__ float fast_sigmoid(float x) { return __builtin_amdgcn_rcpf(1.0f + __builtin_amdgcn_exp2f(-1.4426950408889634f * x)); }
__device__ __forceinline__ float gelu_tanh_f(float x) { const float u2 = 1.5957691216057308f * (x + 0.044715f * x * x * x); return x * fast_sigmoid(u2); }

__device__ __forceinline__ const char* uptr(const char* p) { const unsigned long long v = (unsigned long long)p;
    return (const char*)(((unsigned long long)(unsigned)__builtin_amdgcn_readfirstlane((int)(v >> 32)) << 32) | (unsigned)__builtin_amdgcn_readfirstlane((int)v)); }

template <class Epi, class Sched, bool ALIGN_EPI, bool GATHER, bool FP8 = false>
__device__ __forceinline__ void gemm_phase(PG8_LAS unsigned char* lds, const int wave, const int K, const int lda, const int ldb, const Sched& S, const Epi& E) {
    int tid; asm volatile("v_mbcnt_lo_u32_b32 %0, -1, 0\n\tv_mbcnt_hi_u32_b32 %0, -1, %0" : "=v"(tid)); tid += wave * 64; asm volatile("" : "+v"(tid));
    const int wid = wave, lane = tid & 63, wr = wid >> 2, wc = wid & 3, fr = lane & 15, fq = lane >> 4;
    constexpr int ESZ = FP8 ? 1 : 2;
    int nt = K * ESZ / (BK * 2); asm volatile("" : "+s"(nt));
    unsigned voffA[2][2], voffB[2];
#pragma unroll
    for (int i = 0; i < 2; ++i) { int R, C; stage_rc(tid * 16 + i * 8192, R, C); const int Rb = (R & ~31) + perm32(R & 31); voffB[i] = (unsigned)(Rb * ldb * ESZ + C * 2); }
    const size_t kstep = (size_t)(BK * 2);
    const size_t hstepB = (size_t)HALF * ldb * ESZ;
    const unsigned ldsw = (unsigned)wid * 1024u;
    const int aoff = lds_byte(wr * 64 + fr, FP8 ? fq * 16 : fq * 8), boff = lds_byte(wc * 32 + fr, FP8 ? fq * 16 : fq * 8);
    const int aoff1 = FP8 ? lds_byte(wr * 64 + fr, fq * 16 + 8) : aoff + 1024, boff1 = FP8 ? lds_byte(wc * 32 + fr, fq * 16 + 8) : boff + 1024;
#define PG8_SA(b, h) (((b) * 2 + (h)) * HTB)
#define PG8_SB(b, h) ((4 + (b) * 2 + (h)) * HTB)
#define PG8_STAGE(bufoff, gbase, voff) do { _Pragma("unroll") for (int _i = 0; _i < 2; ++_i) \
        __builtin_amdgcn_global_load_lds((const unsigned*)((const char*)(gbase) + (voff)[_i]), (PG8_LAS unsigned*)(lds + (bufoff) + ldsw + _i * 8192), 16, 0, 0); } while (0)
#define PG8_LD16(p) (*(const PG8_LAS v4i*)(p))
#define PG8_LDA(dst, b, h) do { _Pragma("unroll") for (int m = 0; m < 4; ++m) { if constexpr (FP8) dst##8[m] = __builtin_shufflevector(PG8_LD16(lds + PG8_SA(b, h) + aoff + m * 2048), PG8_LD16(lds + PG8_SA(b, h) + aoff1 + m * 2048), 0, 1, 2, 3, 4, 5, 6, 7); \
        else { dst[m][0] = *(const PG8_LAS bf16x8*)(lds + PG8_SA(b, h) + aoff + m * 2048); dst[m][1] = *(const PG8_LAS bf16x8*)(lds + PG8_SA(b, h) + aoff1 + m * 2048); } } } while (0)
#define PG8_LDB(dst, b, h) do { _Pragma("unroll") for (int n = 0; n < 2; ++n) { if constexpr (FP8) dst##8[n] = __builtin_shufflevector(PG8_LD16(lds + PG8_SB(b, h) + boff + n * 2048), PG8_LD16(lds + PG8_SB(b, h) + boff1 + n * 2048), 0, 1, 2, 3, 4, 5, 6, 7); \
        else { dst[n][0] = *(const PG8_LAS bf16x8*)(lds + PG8_SB(b, h) + boff + n * 2048); dst[n][1] = *(const PG8_LAS bf16x8*)(lds + PG8_SB(b, h) + boff1 + n * 2048); } } } while (0)
#define PG8_MMA(ai, bj, At, Bt) do { __builtin_amdgcn_s_setprio(1); _Pragma("unroll") for (int m = 0; m < 4; ++m) _Pragma("unroll") for (int n = 0; n < 2; ++n) { \
        if constexpr (FP8) acc[ai][bj][m][n] = __builtin_amdgcn_mfma_scale_f32_16x16x128_f8f6f4(Bt##8[n], At##8[m], acc[ai][bj][m][n], 0, 0, 0, f8sc, 0, f8sc); \
        else { _Pragma("unroll") for (int k = 0; k < 2; ++k) acc[ai][bj][m][n] = __builtin_amdgcn_mfma_f32_16x16x32_bf16(Bt[n][k], At[m][k], acc[ai][bj][m][n], 0, 0, 0); } } \
        __builtin_amdgcn_s_setprio(0); } while (0)
#define PG8_WAIT_V(n) asm volatile("s_waitcnt vmcnt(" #n ")" ::: "memory")
#define PG8_WAIT_L(n) asm volatile("s_waitcnt lgkmcnt(" #n ")" ::: "memory")
#define PG8_BAR __builtin_amdgcn_s_barrier()
#define PG8_SCHED __builtin_amdgcn_sched_barrier(0)
#define PG8_VOFF(dst, u) do { _Pragma("unroll") for (int _i = 0; _i < 2; ++_i) { int _R, _C; stage_rc(tid * 16 + _i * 8192, _R, _C); _Pragma("unroll") for (int _h = 0; _h < 2; ++_h) { \
        int _row = _R + _h * HALF; if constexpr (GATHER) _row = S.arow(u, _row); dst[_h][_i] = (unsigned)(_row * lda * ESZ + _C * 2); } } } while (0)
    int f8sc = 0x7F7F7F7F; asm volatile("" : "+v"(f8sc));
    Unit cur, nxt; int ui = 0;
    if (!S.next(0, cur)) return;
    f32x4 acc[2][2][4][2];
#pragma unroll
    for (int a = 0; a < 2; ++a)
#pragma unroll
        for (int b = 0; b < 2; ++b)
#pragma unroll
            for (int m = 0; m < 4; ++m)
#pragma unroll
                for (int n = 0; n < 2; ++n) acc[a][b][m][n] = (f32x4){0.f, 0.f, 0.f, 0.f};
    bf16x8 At[4][2], B0[2][2], B1[2][2]; v8i At8[4], B08[2], B18[2];
    PG8_VOFF(voffA, cur);
    const char* cA = cur.A; const char* cB = cur.B;
    PG8_STAGE(PG8_SB(0, 0), cB, voffB); PG8_STAGE(PG8_SB(0, 1), cB + hstepB, voffB); PG8_STAGE(PG8_SA(0, 0), cA, voffA[0]); PG8_STAGE(PG8_SA(0, 1), cA, voffA[1]);
    if (wr == 1) PG8_BAR;
    PG8_WAIT_V(2); PG8_BAR;
    PG8_STAGE(PG8_SB(1, 0), cB + kstep, voffB); PG8_STAGE(PG8_SA(1, 0), cA + kstep, voffA[0]); PG8_STAGE(PG8_SB(1, 1), cB + hstepB + kstep, voffB);
    PG8_WAIT_V(6); PG8_BAR;
    for (;;) {
        const bool has_next = S.next(ui + 1, nxt);
        const char* nA = has_next ? nxt.A : cA; const char* nB = has_next ? nxt.B : cB;
        for (int t = 0; t < nt; t += 2) {
            const bool last = (t == nt - 2);
            const char* a1 = uptr(cA + (size_t)(t + 1) * kstep);
            const char* a2 = uptr(last ? nA : cA + (size_t)(t + 2) * kstep); const char* b2 = uptr(last ? nB : cB + (size_t)(t + 2) * kstep);
            const char* a3 = a2 + kstep; const char* b3 = b2 + kstep;
            E.khook(acc, cur, t, nt, wr, fr);
            asm volatile("" : "+v"(voffA[0][0]), "+v"(voffA[0][1]), "+v"(voffA[1][0]), "+v"(voffA[1][1]), "+v"(voffB[0]), "+v"(voffB[1]));
            PG8_LDB(B0, 0, 0); PG8_LDB(B1, 0, 1); PG8_SCHED; PG8_LDA(At, 0, 0); PG8_STAGE(PG8_SA(1, 1), a1, voffA[1]);
            if constexpr (GATHER) { if (last && has_next) { PG8_VOFF(voffA, nxt); } }
            PG8_WAIT_V(8); PG8_WAIT_L(0); PG8_BAR; PG8_MMA(0, 0, At, B0); PG8_MMA(0, 1, At, B1); PG8_BAR; PG8_SCHED;
            PG8_LDA(At, 0, 1); PG8_STAGE(PG8_SB(0, 0), b2, voffB); PG8_STAGE(PG8_SB(0, 1), b2 + hstepB, voffB); PG8_STAGE(PG8_SA(0, 0), a2, voffA[0]);
            PG8_WAIT_V(8); PG8_WAIT_L(0); PG8_BAR; PG8_MMA(1, 0, At, B0); PG8_MMA(1, 1, At, B1); PG8_BAR; PG8_SCHED;
            PG8_LDB(B0, 1, 0); PG8_LDB(B1, 1, 1); PG8_SCHED; PG8_LDA(At, 1, 0); PG8_STAGE(PG8_SA(0, 1), a2, voffA[1]);
            PG8_WAIT_V(8); PG8_WAIT_L(0); PG8_BAR; PG8_MMA(0, 0, At, B0); PG8_MMA(0, 1, At, B1); PG8_BAR; PG8_SCHED;
            PG8_LDA(At, 1, 1); PG8_STAGE(PG8_SB(1, 0), b3, voffB); PG8_STAGE(PG8_SB(1, 1), b3 + hstepB, voffB); PG8_STAGE(PG8_SA(1, 0), a3, voffA[0]);
            PG8_WAIT_V(8); PG8_WAIT_L(0); PG8_BAR; PG8_MMA(1, 0, At, B0); PG8_MMA(1, 1, At, B1); PG8_BAR; PG8_SCHED;
        }
        if constexpr (ALIGN_EPI) { if (wr == 0) PG8_BAR; }
        if constexpr (FP8) { PG8_SCHED; asm volatile("s_nop 15\n\ts_nop 15\n\ts_nop 15" ::: "memory"); PG8_SCHED; }
        if constexpr (!Epi::AFTER_DRAIN) { E(acc, cur, wr, wc, fr, fq); }
        if (!has_next) break;
#pragma unroll
        for (int a = 0; a < 2; ++a)
#pragma unroll
            for (int b = 0; b < 2; ++b)
#pragma unroll
                for (int m = 0; m < 4; ++m)
#pragma unroll
                    for (int n = 0; n < 2; ++n) acc[a][b][m][n] = (f32x4){0.f, 0.f, 0.f, 0.f};
        cur = nxt; cA = nA; cB = nB; ++ui;
        if constexpr (ALIGN_EPI) { if (wr == 1) PG8_BAR; }
    }
    PG8_WAIT_V(0);
    if constexpr (!ALIGN_EPI) { if (wr == 0) PG8_BAR; }
    PG8_BAR;
    if constexpr (Epi::AFTER_DRAIN) { E.fused(acc, cur, wr, wc, fr, fq, lds); }
#undef PG8_SA
#undef PG8_SB
#undef PG8_STAGE
#undef PG8_LDA
#undef PG8_LDB
#undef PG8_MMA
#undef PG8_LD16
#undef PG8_WAIT_V
#undef PG8_WAIT_L
#undef PG8_BAR
#undef PG8_SCHED
#undef PG8_VOFF
}
}
namespace pg8 {
struct EpiBase {
    static constexpr bool AFTER_DRAIN = false;
    __device__ __forceinline__ void khook(f32x4 (&)[2][2][4][2], const Unit&, int, int, int, int) const {}
};
#define EPI_LOOP_ROWS for (int ai = 0; ai < 2; ++ai) _Pragma("unroll") for (int m = 0; m < 4; ++m)
typedef unsigned u32x2 __attribute__((ext_vector_type(2)));
__device__ __forceinline__ u32x2 pack8_fp8(const f32x4 v0, const f32x4 v1) { u32x2 w; unsigned a = 0, b = 0;
    a = __builtin_amdgcn_cvt_pk_fp8_f32(v0[0], v0[1], a, false); a = __builtin_amdgcn_cvt_pk_fp8_f32(v0[2], v0[3], a, true);
    b = __builtin_amdgcn_cvt_pk_fp8_f32(v1[0], v1[1], b, false); b = __builtin_amdgcn_cvt_pk_fp8_f32(v1[2], v1[3], b, true); w.x = a; w.y = b; return w; }
__device__ __forceinline__ u32x4 pack8(const f32x4 v0, const f32x4 v1) { u32x4 w; w.x = cvt_pk_bf16(v0[0], v0[1]); w.y = cvt_pk_bf16(v0[2], v0[3]); w.z = cvt_pk_bf16(v1[0], v1[1]); w.w = cvt_pk_bf16(v1[2], v1[3]); return w; }

struct EpiZ : EpiBase {
    bf16_t* Q; bf16_t* Ue; const float* r0; float c2;
    __device__ __forceinline__ void operator()(const f32x4 (&acc)[2][2][4][2], const Unit& u, int wr, int wc, int fr, int fq) const {
        const int sect = u.pn >> 2, colt = (u.pn & 3) * BM, row0 = u.pm * BM + wr * 64 + fr;
        bf16_t* base = Q + (size_t)sect * 16384 * 1024;
        const float sc = sect == 0 ? c2 : 1.f;
#pragma unroll
        EPI_LOOP_ROWS { const int row = row0 + ai * HALF + m * 16; const float rs = r0[row] * sc;
#pragma unroll
            for (int bj = 0; bj < 2; ++bj) { const int col = colt + bj * HALF + wc * 32 + 8 * fq;
                const u32x4 w = pack8(acc[ai][bj][m][0] * rs, acc[ai][bj][m][1] * rs);
                if (sect < 3) *(u32x4*)(base + (size_t)row * 1024 + col) = w;
                else { const int g = col >> 4, half = (col >> 3) & 1, b = row >> 12, t = row & 4095, c = t >> 4, j = t & 15;
                       *(u32x4*)(Ue + ((size_t)((g * 4 + b) * 256 + c) * 384 + j * 16 + half * 8)) = w; } } }
    }
};
struct EpiE {
    static constexpr bool AFTER_DRAIN = true;
    __device__ __forceinline__ void khook(f32x4 (&)[2][2][4][2], const Unit&, int, int, int, int) const {}
    __device__ __forceinline__ void fused(const f32x4 (&acc)[2][2][4][2], const Unit&, int wr, int wc, int fr, int fq, PG8_LAS unsigned char* lds) const {
        PG8_LAS float* Eo = (PG8_LAS float*)lds;
#pragma unroll
        EPI_LOOP_ROWS { const int row = wr * 64 + fr + ai * HALF + m * 16; const int col = wc * 32 + 8 * fq;
            *(PG8_LAS f32x4*)(Eo + row * 128 + col) = acc[ai][0][m][0]; *(PG8_LAS f32x4*)(Eo + row * 128 + col + 4) = acc[ai][0][m][1]; }
    }
};
struct EpiY : EpiBase {
    bf16_t* s1;
    __device__ __forceinline__ void operator()(const f32x4 (&acc)[2][2][4][2], const Unit& u, int wr, int wc, int fr, int fq) const {
        const int g = u.x0, b = u.x1;
#pragma unroll
        EPI_LOOP_ROWS { const int c = wr * 64 + fr + ai * HALF + m * 16;
#pragma unroll
            for (int bj = 0; bj < 2; ++bj) { const int col = bj * HALF + wc * 32 + 8 * fq, i = col >> 4, h0 = col & 15;
                f32x4 v0 = acc[ai][bj][m][0], v1 = acc[ai][bj][m][1];
#pragma unroll
                for (int q = 0; q < 4; ++q) { v0[q] = gelu_tanh_f(v0[q]); v1[q] = gelu_tanh_f(v1[q]); }
                *(u32x4*)(s1 + (size_t)(b * 4096 + c * 16 + i) * 1024 + g * 16 + h0) = pack8(v0, v1); } }
    }
};
struct EpiGlu : EpiBase {
    const bf16_t* s1; const float* bias; bf16_t* scat; float* ssq;
    __device__ __forceinline__ void operator()(const f32x4 (&acc)[2][2][4][2], const Unit& u, int wr, int wc, int fr, int fq) const {
        const int row0 = u.pm * BM + wr * 64 + fr, col0 = u.pn * BM + wc * 32 + 8 * fq;
        f32x4 bv[2][2];
#pragma unroll
        for (int bj = 0; bj < 2; ++bj)
#pragma unroll
            for (int n = 0; n < 2; ++n) bv[bj][n] = *(const f32x4*)(bias + col0 + bj * HALF + 4 * n);
#pragma unroll
        EPI_LOOP_ROWS { const int row = row0 + ai * HALF + m * 16; float q = 0.f;
#pragma unroll
            for (int bj = 0; bj < 2; ++bj) { const int col = col0 + bj * HALF;
                const u32x4 sv = *(const u32x4*)(s1 + (size_t)row * 1024 + col);
                f32x4 v0 = acc[ai][bj][m][0] + bv[bj][0], v1 = acc[ai][bj][m][1] + bv[bj][1];
                v0[0] = bf_lo(sv.x) * fast_sigmoid(v0[0]); v0[1] = bf_hi(sv.x) * fast_sigmoid(v0[1]); v0[2] = bf_lo(sv.y) * fast_sigmoid(v0[2]); v0[3] = bf_hi(sv.y) * fast_sigmoid(v0[3]);
                v1[0] = bf_lo(sv.z) * fast_sigmoid(v1[0]); v1[1] = bf_hi(sv.z) * fast_sigmoid(v1[1]); v1[2] = bf_lo(sv.w) * fast_sigmoid(v1[2]); v1[3] = bf_hi(sv.w) * fast_sigmoid(v1[3]);
                const u32x4 w = pack8(v0, v1); *(u32x4*)(scat + (size_t)row * 2048 + col) = w;
                const float e0 = bf_lo(w.x), e1 = bf_hi(w.x), e2 = bf_lo(w.y), e3 = bf_hi(w.y), e4 = bf_lo(w.z), e5 = bf_hi(w.z), e6 = bf_lo(w.w), e7 = bf_hi(w.w);
                q += (e0 * e0 + e1 * e1) + (e2 * e2 + e3 * e3) + (e4 * e4 + e5 * e5) + (e6 * e6 + e7 * e7); }
            q += __shfl_xor(q, 16); q += __shfl_xor(q, 32);
            if (fq == 0) ssq[(size_t)row * 16 + u.pn * 4 + wc] = q; }
    }
};
struct EpiRes1 {
    static constexpr bool AFTER_DRAIN = false;
    const float* x; bf16_t* x1b; unsigned char* x1f8; float* ssq; const PG8_LAS float* rsT;
    __device__ __forceinline__ void khook(f32x4 (&acc)[2][2][4][2], const Unit& u, int t, int nt, int wr, int fr) const {
        if (t * 2 == nt) {
#pragma unroll
            for (int ai = 0; ai < 2; ++ai)
#pragma unroll
                for (int m = 0; m < 4; ++m) { const float r = rsT[u.x0 * 256 + ai * HALF + wr * 64 + m * 16 + fr];
#pragma unroll
                    for (int bj = 0; bj < 2; ++bj)
#pragma unroll
                        for (int n = 0; n < 2; ++n) acc[ai][bj][m][n] = acc[ai][bj][m][n] * r; }
        }
    }
    __device__ __forceinline__ void operator()(const f32x4 (&acc)[2][2][4][2], const Unit& u, int wr, int wc, int fr, int fq) const {
        const int row0 = u.pm * BM + wr * 64 + fr, col0 = u.pn * BM + wc * 32 + 8 * fq;
#pragma unroll
        EPI_LOOP_ROWS { const int row = row0 + ai * HALF + m * 16; float s = 0.f;
#pragma unroll
            for (int bj = 0; bj < 2; ++bj) { const size_t off = (size_t)row * 2048 + col0 + bj * HALF;
                const u32x4 xv = __builtin_nontemporal_load((const u32x4*)(x1b + off));
                f32x4 v0 = acc[ai][bj][m][0], v1 = acc[ai][bj][m][1];
                v0[0] += bf_lo(xv.x); v0[1] += bf_hi(xv.x); v0[2] += bf_lo(xv.y); v0[3] += bf_hi(xv.y); v1[0] += bf_lo(xv.z); v1[1] += bf_hi(xv.z); v1[2] += bf_lo(xv.w); v1[3] += bf_hi(xv.w);
                s += (v0[0] * v0[0] + v0[1] * v0[1]) + (v0[2] * v0[2] + v0[3] * v0[3]) + (v1[0] * v1[0] + v1[1] * v1[1]) + (v1[2] * v1[2] + v1[3] * v1[3]);
                *(u32x4*)(x1b + off) = pack8(v0, v1); *(u32x2*)(x1f8 + off) = pack8_fp8(v0, v1); }
            s += __shfl_xor(s, 16); s += __shfl_xor(s, 32);
            if (fq == 0) ssq[(size_t)row * 32 + u.pn * 4 + wc] = s; }
    }
};
struct EpiPP : EpiBase {
    unsigned char* pp;
    __device__ __forceinline__ void operator()(const f32x4 (&acc)[2][2][4][2], const Unit& u, int wr, int wc, int fr, int fq) const {
        const int row0 = u.pm * BM + wr * 64 + fr, col0 = u.pn * BM + wc * 32 + 8 * fq;
#pragma unroll
        EPI_LOOP_ROWS { const int row = row0 + ai * HALF + m * 16;
#pragma unroll
            for (int bj = 0; bj < 2; ++bj) *(u32x2*)(pp + (size_t)row * 2048 + col0 + bj * HALF) = pack8_fp8(acc[ai][bj][m][0] * 16.f, acc[ai][bj][m][1] * 16.f); }
    }
};
struct EpiUp : EpiBase {
    const float* row_r; unsigned char* hmid;
    __device__ __forceinline__ void operator()(const f32x4 (&acc)[2][2][4][2], const Unit& u, int wr, int wc, int fr, int fq) const {
        const int rl0 = wr * 64 + fr, col = u.pn * HALF + wc * 32 + 8 * fq;
#pragma unroll
        EPI_LOOP_ROWS { const int rl = rl0 + ai * HALF + m * 16; const float r = row_r[u.x0 + rl] * 0.015625f;
            f32x4 o0, o1;
#pragma unroll
            for (int q = 0; q < 4; ++q) { const float a = acc[ai][0][m][0][q] * r, b = acc[ai][1][m][0][q] * r; o0[q] = a * fast_sigmoid(a) * b;
                                          const float c = acc[ai][0][m][1][q] * r, d = acc[ai][1][m][1][q] * r; o1[q] = c * fast_sigmoid(c) * d; }
            if (rl >= u.pm) { o0 = (f32x4){0.f, 0.f, 0.f, 0.f}; o1 = o0; }
            *(u32x2*)(hmid + (size_t)(u.x1 * BM + rl) * 512 + col) = pack8_fp8(o0, o1); }
    }
};
struct EpiDown : EpiBase {
    const int* row_ts; const float* row_w; unsigned char* contrib;
    __device__ __forceinline__ void operator()(const f32x4 (&acc)[2][2][4][2], const Unit& u, int wr, int wc, int fr, int fq) const {
        const int rl0 = wr * 64 + fr, col0 = u.pn * BM + wc * 32 + 8 * fq;
#pragma unroll
        EPI_LOOP_ROWS { const int rl = rl0 + ai * HALF + m * 16;
            if (rl < u.x1) { const int ts = row_ts[u.x0 + rl]; const float w = row_w[u.x0 + rl] * 0.5f;
                unsigned char* dst = contrib + ((size_t)(ts & 1) * 16384 + (size_t)(ts >> 1)) * 2048 + col0;
#pragma unroll
                for (int bj = 0; bj < 2; ++bj) *(u32x2*)(dst + bj * HALF) = pack8_fp8(acc[ai][bj][m][0] * w, acc[ai][bj][m][1] * w); } }
    }
};
struct EpiGate : EpiBase {
    const bf16_t* x2b; const unsigned char* pp; const float* r2; bf16_t* x3b; float* ssq;
    __device__ __forceinline__ void operator()(const f32x4 (&acc)[2][2][4][2], const Unit& u, int wr, int wc, int fr, int fq) const {
        const int row0 = u.pm * BM + wr * 64 + fr, col0 = u.pn * BM + wc * 32 + 8 * fq;
#pragma unroll
        EPI_LOOP_ROWS { const int row = row0 + ai * HALF + m * 16; const float r = r2[row] * 0.015625f; float s = 0.f;
#pragma unroll
            for (int bj = 0; bj < 2; ++bj) { const size_t off = (size_t)row * 2048 + col0 + bj * HALF;
                const u32x4 xv = __builtin_nontemporal_load((const u32x4*)(x2b + off)); const u32x2 pv = __builtin_nontemporal_load((const u32x2*)(pp + off));
                const f32x2 p01 = __builtin_amdgcn_cvt_pk_f32_fp8(pv.x, false), p23 = __builtin_amdgcn_cvt_pk_f32_fp8(pv.x, true), p45 = __builtin_amdgcn_cvt_pk_f32_fp8(pv.y, false), p67 = __builtin_amdgcn_cvt_pk_f32_fp8(pv.y, true);
                f32x4 v0, v1;
                v0[0] = bf_lo(xv.x) + fast_sigmoid(acc[ai][bj][m][0][0] * r) * (p01[0] * 0.0625f); v0[1] = bf_hi(xv.x) + fast_sigmoid(acc[ai][bj][m][0][1] * r) * (p01[1] * 0.0625f);
                v0[2] = bf_lo(xv.y) + fast_sigmoid(acc[ai][bj][m][0][2] * r) * (p23[0] * 0.0625f); v0[3] = bf_hi(xv.y) + fast_sigmoid(acc[ai][bj][m][0][3] * r) * (p23[1] * 0.0625f);
                v1[0] = bf_lo(xv.z) + fast_sigmoid(acc[ai][bj][m][1][0] * r) * (p45[0] * 0.0625f); v1[1] = bf_hi(xv.z) + fast_sigmoid(acc[ai][bj][m][1][1] * r) * (p45[1] * 0.0625f);
                v1[2] = bf_lo(xv.w) + fast_sigmoid(acc[ai][bj][m][1][2] * r) * (p67[0] * 0.0625f); v1[3] = bf_hi(xv.w) + fast_sigmoid(acc[ai][bj][m][1][3] * r) * (p67[1] * 0.0625f);
                s += (v0[0] * v0[0] + v0[1] * v0[1]) + (v0[2] * v0[2] + v0[3] * v0[3]) + (v1[0] * v1[0] + v1[1] * v1[1]) + (v1[2] * v1[2] + v1[3] * v1[3]);
                *(u32x4*)(x3b + off) = pack8(v0, v1); }
            s += __shfl_xor(s, 16); s += __shfl_xor(s, 32);
            if (fq == 0) ssq[(size_t)row * 32 + u.pn * 4 + wc] = s; }
    }
};
#undef EPI_LOOP_ROWS
}
namespace attn_body {
using bf16=__hip_bfloat16;
using bf16x8=__attribute__((ext_vector_type(8)))short;
using s16x4=__attribute__((ext_vector_type(4)))short;
using f32x16=__attribute__((ext_vector_type(16)))float;
using u32x4=__attribute__((ext_vector_type(4)))unsigned;
constexpr int SEQ=4096,D=64,DM=1024,SPITCH=2048;
constexpr int NW=8,QBLK=32,QB=128,KVBLK=64,NQB=SEQ/QB;
constexpr int LUTN=384;
__device__ __forceinline__ int crow(int r,int hi){return (r&3)+8*(r>>2)+4*hi;}
#define SBAR() __builtin_amdgcn_sched_barrier(0)
typedef __attribute__((address_space(3))) const char* lds_cptr;
typedef __attribute__((address_space(3))) const float* lds_fptr;
__device__ __forceinline__ void cmask(f32x16&p0,f32x16&p1,int jb,int qrel,int hi){
  const float NEG=-INFINITY; int kb=64*jb+4*hi;
  #pragma unroll
  for(int r=0;r<16;++r){int kv=kb+(r&3)+8*(r>>2); if(kv>qrel)p0[r]=NEG; if(kv+32>qrel)p1[r]=NEG;}
}
__device__ __forceinline__ void cbias(f32x16&p0,f32x16&p1,int jb,int qrel,int hi,lds_fptr lut){
  const lds_fptr pb=lut+(qrel-64*jb-4*hi+68);
  #pragma unroll
  for(int g=0;g<4;++g){
    #pragma unroll
    for(int q=0;q<4;++q){const int r=4*g+q, ko=(r&3)+8*(r>>2); p0[r]+=pb[59-ko]; p1[r]+=pb[27-ko];}
    __builtin_amdgcn_sched_barrier(0);
  }
}
constexpr int NSLOT=3, KSLOT=8192, VSLOT=16384;
constexpr int LDS_K0=0, LDS_K1=NSLOT*KSLOT, LDS_V=2*NSLOT*KSLOT, LDS_WS=LDS_V+NSLOT*VSLOT, LDS_Q=LDS_WS+NW*64*4, LDS_LUT=LDS_Q+NW*4096, LDS_BYTES=LDS_LUT+1536;
constexpr int LDS_Y0=0, LDS_Y1=65536;
static_assert(LDS_Y1+65536<=LDS_LUT,"stage overlaps the bias table");
typedef float f32x4e __attribute__((ext_vector_type(4))); typedef unsigned u32x2e __attribute__((ext_vector_type(2)));
constexpr float C2=0.125f*1.4426950408889634f;
__device__ __forceinline__ void glds16(const void*gsrc,unsigned lds_dst){unsigned keep;
  asm volatile("s_mov_b32 %0, m0\n\ts_mov_b32 m0, %2\n\ts_nop 0\n\tglobal_load_lds_dwordx4 %1, off\n\ts_mov_b32 m0, %0":"=&s"(keep):"v"(gsrc),"s"(lds_dst):"memory");}
__device__ __forceinline__ float max3f(float a,float b,float c){float r;asm("v_max3_f32 %0, %1, %2, %3":"=v"(r):"v"(a),"v"(b),"v"(c));return r;}
__device__ __forceinline__ float max2f(float a,float b){float r;asm("v_max_f32_e32 %0, %1, %2":"=v"(r):"v"(a),"v"(b));return r;}
__device__ __forceinline__ float fadd_s(float a,float b){float r;asm("v_add_f32_e32 %0, %1, %2":"=v"(r):"v"(a),"v"(b));return r;}
__device__ __forceinline__ float fsub_s(float a,float b){float r;asm("v_sub_f32_e32 %0, %1, %2":"=v"(r):"v"(a),"v"(b));return r;}
typedef float f32x2_t __attribute__((ext_vector_type(2))); typedef __bf16 bf16x2_t __attribute__((ext_vector_type(2)));
__device__ __forceinline__ unsigned cvtpk_s(float lo,float hi){f32x2_t v={lo,hi};bf16x2_t b=__builtin_convertvector(v,bf16x2_t);return __builtin_bit_cast(unsigned,b);}
#define WAIT_BAR(N) asm volatile("s_waitcnt vmcnt(" #N ") lgkmcnt(0)\n\ts_barrier":::"memory")
#define LDSB8(p) (*(const __attribute__((address_space(3))) bf16x8*)(p))
__device__ __forceinline__ void qkt(f32x16&p0,f32x16&p1,lds_cptr kp,lds_cptr qp,const f32x16&negm){
  #pragma unroll
  for(int d0=0;d0<4;++d0){
    const bf16x8 b0=LDSB8(kp+d0*2048), b1=LDSB8(kp+d0*2048+512), qf=LDSB8(qp+d0*1024);
    if(d0==0){p0=__builtin_amdgcn_mfma_f32_32x32x16_bf16(b0,qf,negm,0,0,0);p1=__builtin_amdgcn_mfma_f32_32x32x16_bf16(b1,qf,negm,0,0,0);}
    else{p0=__builtin_amdgcn_mfma_f32_32x32x16_bf16(b0,qf,p0,0,0,0);p1=__builtin_amdgcn_mfma_f32_32x32x16_bf16(b1,qf,p1,0,0,0);}}
}
typedef short v4i16_t __attribute__((ext_vector_type(4)));
__device__ __forceinline__ void kload8(bf16x8*kf,lds_cptr kp){
  kf[0]=LDSB8(kp);      kf[1]=LDSB8(kp+512);  kf[2]=LDSB8(kp+2048); kf[3]=LDSB8(kp+2560);
  kf[4]=LDSB8(kp+4096); kf[5]=LDSB8(kp+4608); kf[6]=LDSB8(kp+6144); kf[7]=LDSB8(kp+6656);
}
__device__ __forceinline__ void kload2(bf16x8*kf,lds_cptr kp,int j){ kf[2*j]=LDSB8(kp+j*2048); kf[2*j+1]=LDSB8(kp+j*2048+512); }
__device__ __forceinline__ s16x4 vtr(lds_cptr p){ return __builtin_bit_cast(s16x4,__builtin_amdgcn_ds_read_tr16_b64_v4i16((__attribute__((address_space(3))) v4i16_t*)p)); }
__device__ __forceinline__ float rowmax(const f32x16&p0,const f32x16&p1){
  float a=max3f(p0[0],p0[1],p1[0]),b=max3f(p0[2],p0[3],p1[1]);a=max3f(a,p1[2],p1[3]);
  #pragma unroll
  for(int r=4;r<16;r+=4){a=max3f(a,p0[r],p0[r+1]);b=max3f(b,p0[r+2],p0[r+3]);a=max3f(a,p1[r],p1[r+1]);b=max3f(b,p1[r+2],p1[r+3]);}
  const float m=max2f(a,b);
  auto rr=__builtin_amdgcn_permlane32_swap(__float_as_uint(m),__float_as_uint(m),false,false);
  return max2f(__uint_as_float(rr[0]),__uint_as_float(rr[1]));
}
__device__ __forceinline__ void pv4(f32x16*o,lds_cptr vp,bf16x8 pa0,bf16x8 pa1,bf16x8 pa2,bf16x8 pa3){
  #pragma unroll
  for(int d0=0;d0<4;++d0){s16x4 lo[4],hi[4];
    #pragma unroll
    for(int ks=0;ks<4;++ks){ lo[ks]=vtr(vp+d0*4096+ks*1024); hi[ks]=vtr(vp+d0*4096+ks*1024+512); }
    #define PK(k) (bf16x8){lo[k][0],lo[k][1],lo[k][2],lo[k][3],hi[k][0],hi[k][1],hi[k][2],hi[k][3]}
    o[d0]=__builtin_amdgcn_mfma_f32_32x32x16_bf16(pa0,PK(0),o[d0],0,0,0);
    o[d0]=__builtin_amdgcn_mfma_f32_32x32x16_bf16(pa1,PK(1),o[d0],0,0,0);
    o[d0]=__builtin_amdgcn_mfma_f32_32x32x16_bf16(pa2,PK(2),o[d0],0,0,0);
    o[d0]=__builtin_amdgcn_mfma_f32_32x32x16_bf16(pa3,PK(3),o[d0],0,0,0);
    #undef PK
  }
}

template<int THRL> __device__ __forceinline__ void attn_unit(int b,int h,int qb,const bf16*Q,const bf16*__restrict__ K,const bf16*__restrict__ V,bf16*scat,const float*lutg,const float*subg,float nlam,char*shm,int wave){
  int tid; asm volatile("v_mbcnt_lo_u32_b32 %0, -1, 0\n\tv_mbcnt_hi_u32_b32 %0, -1, %0":"=v"(tid)); tid+=wave*64;
  const int lane=tid&63,r32=lane&31,hi=lane>>5; const int wid=wave; const int cm=wid>>2,wq=wid&3;
  const long rowbase=(long)b*SEQ; const int q0=qb*QB;
  const bf16*Qw=Q+(rowbase+q0+wq*QBLK)*DM+(2*h+cm)*D;
  const bf16*Kh=K+rowbase*DM+(2*h)*D,*Vh=V+rowbase*DM+h*128;
  const unsigned lds0=(unsigned)(uintptr_t)shm;
  float*wsf=(float*)(shm+LDS_WS)+wid*64;
  const bf16*ksrc=Kh+(long)lane*DM+wid*8;
  const bf16*vsrc=Vh+(long)(16*(wid&3)+(lane>>2))*DM+(wid>>2)*32+(lane&3)*8;
  const unsigned kdst=lds0+LDS_K0+wid*1024, vdst=lds0+LDS_V+wid*1024;
  #define DMA_K(t,slot) do{ glds16(ksrc+(long)(t)*KVBLK*DM,(unsigned)__builtin_amdgcn_readfirstlane(kdst+(slot))); glds16(ksrc+D+(long)(t)*KVBLK*DM,(unsigned)__builtin_amdgcn_readfirstlane(kdst+LDS_K1+(slot))); }while(0)
  #define DMA_V(t,slot) do{ glds16(vsrc+(long)(t)*KVBLK*DM,(unsigned)__builtin_amdgcn_readfirstlane(vdst+2*(slot))); glds16(vsrc+64+(long)(t)*KVBLK*DM,(unsigned)__builtin_amdgcn_readfirstlane(vdst+8192+2*(slot))); }while(0)
  bf16x8 kf[8];
  const lds_cptr shm3=(lds_cptr)shm; const lds_cptr kp0=shm3+(cm?LDS_K1:LDS_K0)+hi*1024+r32*16; const lds_cptr vp0=shm3+LDS_V+((lane>>4)&1)*32+(lane&3)*8+(4*hi+((lane&15)>>2))*64;
  const lds_cptr qp=shm3+LDS_Q+wid*4096+lane*16;
  const int NT=(q0+QB)/KVBLK;
  const lds_fptr lut=(lds_fptr)(shm3+LDS_LUT);
  if(tid<LUTN)((__attribute__((address_space(3))) float*)(shm3+LDS_LUT))[tid]=lutg[tid];
  #pragma unroll
  for(int d0=0;d0<4;++d0) glds16(Qw+(long)r32*DM+d0*16+hi*8,(unsigned)__builtin_amdgcn_readfirstlane(lds0+LDS_Q+wid*4096+d0*1024));
  DMA_K(0,0);DMA_V(0,0);DMA_K(1,KSLOT);
  float mhat=0.f,l_reg=0.f;f32x16 o[4];o[0]=f32x16{};o[1]=f32x16{};o[2]=f32x16{};o[3]=f32x16{};f32x16 negm=f32x16{};asm volatile("":"+v"(negm));
  const int qrel=wq*QBLK+r32;
  #define CMASK(P0,P1,t) do{int jb_=(t)-(NT-2); if(jb_>=-2){ if(wq*QBLK-64*jb_-63<128)cbias(P0,P1,jb_,qrel,hi,lut); if(jb_>=0)cmask(P0,P1,jb_,qrel,hi);} }while(0)
  bool resc=false;
  #define RESC() do{ if(resc){ asm volatile("s_waitcnt lgkmcnt(0)":::"memory"); \
      _Pragma("unroll") for(int d_=0;d_<4;++d_) _Pragma("unroll") for(int r=0;r<16;++r)o[d_][r]*=wsf[crow(r,hi)]; } }while(0)
  f32x16 c0,c1; u32x4 pa0,pa1,pa2,pa3,pb0,pb1,pb2,pb3;
  int sl_prev=0,sl_cur=0,sl_next=KSLOT;
  #define ROT() do{sl_prev=sl_cur;sl_cur=sl_next;sl_next=(sl_next==(NSLOT-1)*KSLOT)?0:sl_next+KSLOT;}while(0)
  if(NT>2){ DMA_K(2,2*KSLOT); WAIT_BAR(6); }
  else { WAIT_BAR(4); }
  #define PKW(P,B) cvtpk_s(P[B],P[B+1])
  qkt(c0,c1,kp0,qp,negm);asm volatile("s_nop 15\n\ts_nop 7":"+v"(c0),"+v"(c1));CMASK(c0,c1,0);
  { const float rm=rowmax(c0,c1); mhat=fadd_s(mhat,rm);
    _Pragma("unroll") for(int r=0;r<16;++r){c0[r]=fsub_s(c0[r],rm);c1[r]=fsub_s(c1[r],rm);}
    _Pragma("unroll") for(int r=0;r<16;++r)negm[r]=-mhat; asm volatile("":"+v"(negm));
    _Pragma("unroll") for(int r=0;r<16;++r){c0[r]=__builtin_amdgcn_exp2f(c0[r]);c1[r]=__builtin_amdgcn_exp2f(c1[r]);}
    float sacc=c0[0]+c0[1]; _Pragma("unroll") for(int r=2;r<16;++r)sacc+=c0[r]; _Pragma("unroll") for(int r=0;r<16;++r)sacc+=c1[r]; l_reg+=sacc;
    pa0=(u32x4){PKW(c0,0),PKW(c0,2),PKW(c0,4),PKW(c0,6)};pa1=(u32x4){PKW(c0,8),PKW(c0,10),PKW(c0,12),PKW(c0,14)};pa2=(u32x4){PKW(c1,0),PKW(c1,2),PKW(c1,4),PKW(c1,6)};pa3=(u32x4){PKW(c1,8),PKW(c1,10),PKW(c1,12),PKW(c1,14)}; }
  WAIT_BAR(0);
  if(NT>2){DMA_K(3,0);} DMA_V(1,KSLOT);
  ROT();
  kload8(kf,kp0+sl_cur);
  if(NT>2){ WAIT_BAR(4); }
  else { WAIT_BAR(0); }
  s16x4 vlo[8],vhi[8];
  #define PAF(w) __builtin_bit_cast(bf16x8,w)
  #define VFR(i) (bf16x8){vlo[i][0],vlo[i][1],vlo[i][2],vlo[i][3],vhi[i][0],vhi[i][1],vhi[i][2],vhi[i][3]}
  #define PIN(x) asm volatile("":"+v"(x))
  #define MX3(a,b,c) __builtin_fmaxf(__builtin_fmaxf((a),(b)),(c))
  #define EX(v) __builtin_amdgcn_exp2f(v)
  #define VRD(i,kk) do{ vlo[i]=vtr(vp_+(((i)&3)*4096+(2*(kk)+((i)>>2))*1024)); vhi[i]=vtr(vp_+(((i)&3)*4096+(2*(kk)+((i)>>2))*1024+512)); }while(0)
  #define GAPA(MF,i) do{ VRD(i,0); SBAR(); MF; SBAR(); }while(0)
  #define GAPB(MF,X,B,PW,J) do{ MF; X[B]=EX(X[B]); X[B+1]=EX(X[B+1]); sacc+=X[B]; sacc+=X[B+1]; PIN(sacc); PW[J]=PKW(X,B); PIN(PW); SBAR(); }while(0)
  #define KRD(G,j) do{ if(G){ kload2(kf,kp0+sl_next,j); SBAR(); } }while(0)
  #define SOFT(X,B,PW,J) do{ X[B]=EX(X[B]); X[B+1]=EX(X[B+1]); sacc+=X[B]; sacc+=X[B+1]; PIN(sacc); PW[J]=PKW(X,B); PIN(PW); SBAR(); }while(0)
  #define MFO(MF) do{ MF; SBAR(); }while(0)
  #define STEP(PO0,PO1,PO2,PO3,PN0,PN1,PN2,PN3,t,GK,GV,GL) do{ SBAR(); \
    const lds_cptr vp_=vp0+2*sl_prev; bf16x8 qf; \
    qf=LDSB8(qp);      GAPA(c0=__builtin_amdgcn_mfma_f32_32x32x16_bf16(kf[0],qf,negm,0,0,0),0); GAPA(c1=__builtin_amdgcn_mfma_f32_32x32x16_bf16(kf[1],qf,negm,0,0,0),1); \
    qf=LDSB8(qp+1024); GAPA(c0=__builtin_amdgcn_mfma_f32_32x32x16_bf16(kf[2],qf,c0,0,0,0),2);   GAPA(c1=__builtin_amdgcn_mfma_f32_32x32x16_bf16(kf[3],qf,c1,0,0,0),3); \
    qf=LDSB8(qp+2048); GAPA(c0=__builtin_amdgcn_mfma_f32_32x32x16_bf16(kf[4],qf,c0,0,0,0),4);   GAPA(c1=__builtin_amdgcn_mfma_f32_32x32x16_bf16(kf[5],qf,c1,0,0,0),5); \
    qf=LDSB8(qp+3072); GAPA(c0=__builtin_amdgcn_mfma_f32_32x32x16_bf16(kf[6],qf,c0,0,0,0),6);   GAPA(c1=__builtin_amdgcn_mfma_f32_32x32x16_bf16(kf[7],qf,c1,0,0,0),7); \
    if(GK){DMA_K((t)+3,sl_cur);} if(GV){DMA_V((t)+1,sl_next);} \
    CMASK(c0,c1,t); \
    { float a=MX3(c0[0],c0[1],c1[0]),b_=MX3(c0[2],c0[3],c1[1]); a=MX3(a,c1[2],c1[3]); \
      _Pragma("unroll") for(int r=4;r<16;r+=4){a=MX3(a,c0[r],c0[r+1]);b_=MX3(b_,c0[r+2],c0[r+3]);a=MX3(a,c1[r],c1[r+1]);b_=MX3(b_,c1[r+2],c1[r+3]);} \
      float rm=__builtin_fmaxf(a,b_); { auto rr=__builtin_amdgcn_permlane32_swap(__float_as_uint(rm),__float_as_uint(rm),false,false); rm=__builtin_fmaxf(__uint_as_float(rr[0]),__uint_as_float(rr[1])); } \
      resc=false; \
      if(__builtin_expect(__any(rm>(float)THRL),0)){ const float dl=__builtin_fmaxf(rm,0.f); mhat+=dl; \
        _Pragma("unroll") for(int r=0;r<16;++r){c0[r]-=dl;c1[r]-=dl;} \
        _Pragma("unroll") for(int r=0;r<16;++r)negm[r]=-mhat; asm volatile("":"+v"(negm)); \
        const float f=__builtin_amdgcn_exp2f(-dl); l_reg*=f; if(hi==0)wsf[r32]=f; resc=true; } } \
    SBAR(); float sacc=0.f; \
    SOFT(c0,0,PN0,0); SOFT(c0,2,PN0,1); SOFT(c0,4,PN0,2); SOFT(c0,6,PN0,3); SOFT(c0,8,PN1,0); SOFT(c0,10,PN1,1); SOFT(c0,12,PN1,2); SOFT(c0,14,PN1,3); \
    SOFT(c1,0,PN2,0); SOFT(c1,2,PN2,1); SOFT(c1,4,PN2,2); SOFT(c1,6,PN2,3); SOFT(c1,8,PN3,0); SOFT(c1,10,PN3,1); SOFT(c1,12,PN3,2); SOFT(c1,14,PN3,3); \
    SBAR(); asm volatile("s_nop 7"); SBAR(); \
    MFO(o[0]=__builtin_amdgcn_mfma_f32_32x32x16_bf16(PAF(PO0),VFR(0),o[0],0,0,0));  VRD(0,1); SBAR(); \
    MFO(o[1]=__builtin_amdgcn_mfma_f32_32x32x16_bf16(PAF(PO0),VFR(1),o[1],0,0,0));  VRD(1,1); SBAR(); \
    MFO(o[2]=__builtin_amdgcn_mfma_f32_32x32x16_bf16(PAF(PO0),VFR(2),o[2],0,0,0));  VRD(2,1); SBAR(); \
    MFO(o[3]=__builtin_amdgcn_mfma_f32_32x32x16_bf16(PAF(PO0),VFR(3),o[3],0,0,0));  VRD(3,1); SBAR(); \
    MFO(o[0]=__builtin_amdgcn_mfma_f32_32x32x16_bf16(PAF(PO1),VFR(4),o[0],0,0,0));  VRD(4,1); SBAR(); \
    MFO(o[1]=__builtin_amdgcn_mfma_f32_32x32x16_bf16(PAF(PO1),VFR(5),o[1],0,0,0)); VRD(5,1); SBAR(); \
    MFO(o[2]=__builtin_amdgcn_mfma_f32_32x32x16_bf16(PAF(PO1),VFR(6),o[2],0,0,0)); VRD(6,1); SBAR(); \
    MFO(o[3]=__builtin_amdgcn_mfma_f32_32x32x16_bf16(PAF(PO1),VFR(7),o[3],0,0,0)); VRD(7,1); SBAR(); \
    MFO(o[0]=__builtin_amdgcn_mfma_f32_32x32x16_bf16(PAF(PO2),VFR(0),o[0],0,0,0)); \
    KRD(GL,0); MFO(o[1]=__builtin_amdgcn_mfma_f32_32x32x16_bf16(PAF(PO2),VFR(1),o[1],0,0,0)); \
    KRD(GL,1); MFO(o[2]=__builtin_amdgcn_mfma_f32_32x32x16_bf16(PAF(PO2),VFR(2),o[2],0,0,0)); \
    KRD(GL,2); MFO(o[3]=__builtin_amdgcn_mfma_f32_32x32x16_bf16(PAF(PO2),VFR(3),o[3],0,0,0)); \
    KRD(GL,3); MFO(o[0]=__builtin_amdgcn_mfma_f32_32x32x16_bf16(PAF(PO3),VFR(4),o[0],0,0,0)); \
    MFO(o[1]=__builtin_amdgcn_mfma_f32_32x32x16_bf16(PAF(PO3),VFR(5),o[1],0,0,0)); \
    MFO(o[2]=__builtin_amdgcn_mfma_f32_32x32x16_bf16(PAF(PO3),VFR(6),o[2],0,0,0)); \
    MFO(o[3]=__builtin_amdgcn_mfma_f32_32x32x16_bf16(PAF(PO3),VFR(7),o[3],0,0,0)); \
    l_reg+=sacc; \
    }while(0)
  int t=1;
  #undef CMASK
  #define CMASK(P0,P1,t) do{}while(0)
  for(;t+5<NT;t+=2){
    STEP(pa0,pa1,pa2,pa3,pb0,pb1,pb2,pb3,t,true,true,true);     WAIT_BAR(4); RESC(); ROT();
    STEP(pb0,pb1,pb2,pb3,pa0,pa1,pa2,pa3,t+1,true,true,true);   WAIT_BAR(4); RESC(); ROT();
  }
  #undef CMASK
  #define CMASK(P0,P1,t) do{int jb_=(t)-(NT-2); if(jb_>=-2){ if(wq*QBLK-64*jb_-63<128)cbias(P0,P1,jb_,qrel,hi,lut); if(jb_>=0)cmask(P0,P1,jb_,qrel,hi);} }while(0)
  #define ENDW(tt) do{ if((tt)+3<NT){WAIT_BAR(4);} else if((tt)+2<NT){WAIT_BAR(2);} else {WAIT_BAR(0);} }while(0)
  for(;t+1<NT;t+=2){
    STEP(pa0,pa1,pa2,pa3,pb0,pb1,pb2,pb3,t,(t+3<NT),(t+1<NT),(t+1<NT));       ENDW(t);   RESC(); ROT();
    STEP(pb0,pb1,pb2,pb3,pa0,pa1,pa2,pa3,t+1,(t+4<NT),(t+2<NT),(t+2<NT));     ENDW(t+1); RESC(); ROT();
  }
  STEP(pa0,pa1,pa2,pa3,pb0,pb1,pb2,pb3,NT-1,false,false,false); RESC();
  SBAR(); pv4(o,vp0+2*sl_cur,PAF(pb0),PAF(pb1),PAF(pb2),PAF(pb3));
  #undef PKW
  #undef PAF
  #undef VFR
  #undef PIN
  #undef MX3
  #undef GAPA
  #undef GAPB
  #undef SOFT
  #undef MFO
  #undef EX
  #undef VRD
  #undef KRD
  #undef STEP
  #undef ENDW
  {auto rr=__builtin_amdgcn_permlane32_swap(__float_as_uint(l_reg),__float_as_uint(l_reg),false,false);l_reg=__uint_as_float(rr[0])+__uint_as_float(rr[1]);}
  if(hi==0)wsf[32+r32]=l_reg;
  { const float sc=cm?nlam:1.f; asm volatile("s_waitcnt lgkmcnt(0)":::"memory");
    #pragma unroll
    for(int r=0;r<16;++r){ const float rl=__builtin_amdgcn_rcpf(wsf[32+crow(r,hi)])*sc;
      #pragma unroll
      for(int d0=0;d0<4;++d0)o[d0][r]*=rl; } }
  asm volatile("s_waitcnt lgkmcnt(0)\n\ts_barrier":::"memory");
  { float*stg=(float*)(shm+(cm?LDS_Y1:LDS_Y0))+wq*QBLK*128;
    #pragma unroll
    for(int r=0;r<16;++r){const int orow=crow(r,hi);
      #pragma unroll
      for(int d0=0;d0<4;++d0)stg[orow*128+d0*32+r32]=o[d0][r];} }
  asm volatile("s_waitcnt lgkmcnt(0)\n\ts_barrier":::"memory");
  { int l2; asm volatile("v_mbcnt_lo_u32_b32 %0, -1, 0\n\tv_mbcnt_hi_u32_b32 %0, -1, %0":"=v"(l2)); const int half=l2>>5,c4=l2&31;
    const __attribute__((address_space(1))) f32x4e*gp=(const __attribute__((address_space(1))) f32x4e*)(subg+c4*4); asm volatile("":"+v"(gp)); const f32x4e g4=*gp;
    #pragma unroll
    for(int p=0;p<8;++p){ const int row=wave*16+2*p+half;
      const f32x4e a=*(const __attribute__((address_space(3))) f32x4e*)(shm3+LDS_Y0+(row*128+c4*4)*4), c=*(const __attribute__((address_space(3))) f32x4e*)(shm3+LDS_Y1+(row*128+c4*4)*4);
      const f32x4e v=a+c; float q=v[0]*v[0]+v[1]*v[1]+v[2]*v[2]+v[3]*v[3];
      q+=__shfl_xor(q,1); q+=__shfl_xor(q,2); q+=__shfl_xor(q,4); q+=__shfl_xor(q,8); q+=__shfl_xor(q,16);
      const float rs=__builtin_amdgcn_rsqf(q*(1.f/128.f)+1e-5f)*0.8f;
      u32x2e w; w[0]=cvtpk_s(v[0]*rs*g4[0],v[1]*rs*g4[1]); w[1]=cvtpk_s(v[2]*rs*g4[2],v[3]*rs*g4[3]);
      *(u32x2e*)(scat+(rowbase+q0+row)*SPITCH+1024+h*128+c4*4)=w; } }
  asm volatile("s_waitcnt lgkmcnt(0)\n\ts_barrier":::"memory");
  #undef DMA_K
  #undef DMA_V
  #undef CMASK
  #undef RESC
  #undef ROT
}
constexpr int ATTN_LDS_BYTES=LDS_BYTES;
struct AttnTensors { const bf16* Q; const bf16* K; const bf16* V; bf16* scat; const float* lutg; const float* subg; const float* nlam; };
struct AttnUnit { int bh; int qb; };
struct StaticOrder {
  int vcu;
  __device__ __forceinline__ explicit StaticOrder(int grid,int block):vcu((grid%8==0)?(block%8)*(grid/8)+block/8:block){}
  __device__ __forceinline__ bool next(int i,AttnUnit&u)const{ if(i>=4||vcu>=256)return false; const int s=vcu&7; u.bh=vcu>>3; u.qb=(i==0)?s:(i==1)?15-s:(i==2)?16+s:31-s; return true; }
};
template<class Sched,class Hook,int THRL=8> __device__ __forceinline__ void attn_phase(char*lds,const AttnTensors&T,const Sched&S,int wave,const Hook&hook){
  AttnUnit u; const float nlam=*T.nlam;
  int lim_=4; asm volatile("":"+s"(lim_));
  for(int i=0;i<lim_&&S.next(i,u);++i){ hook(i); const int h=u.bh&7,b=u.bh>>3; attn_unit<THRL>(b,h,u.qb,T.Q,T.K,T.V,T.scat,T.lutg+h*LUTN,T.subg,nlam,lds,wave); }
  hook(4);
}
#undef SBAR
#undef WAIT_BAR
#undef LDSB8
}
constexpr int NWAVES = 8;
#ifndef MK_ONE_LAUNCH
#define MK_ONE_LAUNCH 1
#endif
constexpr int NPH = 12;

constexpr int M = 16384, D = 2048, SEQ = 4096, NB = 4;
constexpr int NE = 32, DE = 512, ECAP = 16384, PLE = 256;
constexpr float EPS = 1e-6f;

constexpr size_t MiB = 1u << 20;
constexpr size_t WS_CTL = 0, CTL_ZERO_BYTES = 32768;
constexpr size_t WS_R0 = 1 * MiB, WS_R2 = WS_R0 + 65536, WS_LUT = WS_R2 + 65536, WS_NLAM = WS_LUT + 16384 - 256, WS_SSC = WS_LUT + 16384;
constexpr size_t WS_SSQ1 = 2 * MiB, WS_SSQ3 = 4 * MiB, WS_RTS = 6 * MiB, WS_RW = 8 * MiB, WS_RR = 10 * MiB;
constexpr size_t WS_WIN = 12 * MiB, WS_WGLU = 28 * MiB, WS_WO = 30 * MiB, WS_WPG = 38 * MiB, WS_WPP = 46 * MiB, WS_WR = 47 * MiB, WS_W1T = 48 * MiB, WS_TVT = 56 * MiB, WS_W13 = 68 * MiB, WS_W2 = 132 * MiB, WS_X1F8 = 164 * MiB, WS_X2F8 = 196 * MiB;
constexpr size_t WS_A = 260 * MiB;
constexpr size_t WS_B = 324 * MiB;
constexpr size_t WS_B2 = WS_B + 64 * MiB;
constexpr size_t WS_PP = 452 * MiB, WS_PBF = 516 * MiB, WS_END = 524 * MiB;
constexpr int CW_TMO = 0, CW_CODE = 1, CW_CNT = 64;
constexpr int CW_BAR = 4096;

constexpr int RING_OFF = 0, RING_BYTES = 139264;
constexpr int LDSCTL_OFF = RING_BYTES, MISC_OFF = LDSCTL_OFF + 320;
constexpr int XTRA_OFF = RING_BYTES + 1024;
constexpr int LDS_BYTES = RING_BYTES + 1024 + 8192;
static_assert(XTRA_OFF + 8192 <= LDS_BYTES, "LDS map");

#define GAS __attribute__((address_space(1)))
#define LAS __attribute__((address_space(3)))
typedef unsigned short bf16;
typedef unsigned v4u __attribute__((ext_vector_type(4)));
typedef unsigned v2u __attribute__((ext_vector_type(2)));
typedef float f32x4 __attribute__((ext_vector_type(4)));
typedef short bf16x8 __attribute__((ext_vector_type(8)));
typedef float f32x16 __attribute__((ext_vector_type(16)));
typedef GAS unsigned gu32;
#define RLX_AGENT __ATOMIC_RELAXED, __HIP_MEMORY_SCOPE_AGENT
#define LDS_WAIT() asm volatile("s_waitcnt lgkmcnt(0)" ::: "memory")
#define VM_WAIT() asm volatile("s_waitcnt vmcnt(0)" ::: "memory")
__device__ __forceinline__ unsigned f2bf(float f) { unsigned u = __builtin_bit_cast(unsigned, f); return (u + 0x7fffu + ((u >> 16) & 1u)) >> 16; }
__device__ __forceinline__ unsigned pk2(float lo, float hi) { return f2bf(lo) | (f2bf(hi) << 16); }
__device__ __forceinline__ float bflo(unsigned w) { return __builtin_bit_cast(float, w << 16); }
__device__ __forceinline__ float bfhi(unsigned w) { return __builtin_bit_cast(float, w & 0xffff0000u); }

#define XB_TMO      128
#define XB_XCNT(j)  (256  + 64 * (j))
#define XB_XSUB(j)  (1280 + 64 * (j))
#define XB_XGEN(j)  (2304 + 64 * (j))
#define XB_TOP      3328
#define XB_TOPGEN   3392
#define XCD_BAR_WORDS 3456
#define XB_SPIN_CAP (1u << 18)

__device__ __forceinline__ unsigned xb_ld(unsigned* p)              { return __hip_atomic_load(p, __ATOMIC_RELAXED, __HIP_MEMORY_SCOPE_AGENT); }
__device__ __forceinline__ unsigned xb_add(unsigned* p, unsigned v) { return __hip_atomic_fetch_add(p, v, __ATOMIC_RELAXED, __HIP_MEMORY_SCOPE_AGENT); }
__device__ __forceinline__ unsigned xb_xcc_id() { return (unsigned)__builtin_amdgcn_s_getreg((3 << 11) | 20) & 0xFu; }
#define XB_SPIN(cond, bar) do { unsigned _sp = 0; while (cond) { __builtin_amdgcn_s_sleep(1); \
    if ((++_sp & 255u) == 0u) { if (xb_ld(&(bar)[XB_TMO])) break; if (_sp > XB_SPIN_CAP) { atomicAdd(&(bar)[XB_TMO], 1u); break; } } } } while (0)

struct XcdBarrier {
    unsigned* bar; unsigned x;
    volatile LAS unsigned* st;
};
__device__ __forceinline__ XcdBarrier xcd_barrier_post(unsigned* bar, volatile LAS unsigned* st, bool t0) {
    XcdBarrier b; b.bar = bar; b.x = xb_xcc_id(); b.st = st;
    if (t0) (void)xb_add(&bar[XB_XCNT(b.x)], 1u);
    return b;
}
__device__ __forceinline__ void xcd_barrier_complete(unsigned* bar, unsigned x, unsigned& nloc, unsigned& nx) {
    const unsigned G = gridDim.x * gridDim.y * gridDim.z;
    unsigned sum, cnt, mine, sp = 0u;
    for (;;) {
        sum = 0u; cnt = 0u; mine = 0u;
#pragma unroll
        for (unsigned j = 0; j < 16; ++j) { const unsigned c = xb_ld(&bar[XB_XCNT(j)]); sum += c; cnt += (c > 0u) ? 1u : 0u; mine = (j == x) ? c : mine; }
        if (sum == G) break;
        __builtin_amdgcn_s_sleep(1);
        if ((++sp & 255u) == 0u) { if (xb_ld(&bar[XB_TMO])) break; if (sp > XB_SPIN_CAP) { atomicAdd(&bar[XB_TMO], 1u); break; } }
    }
    nloc = mine > 0u ? mine : 1u; nx = cnt > 0u ? cnt : 1u;
}
__device__ __forceinline__ void xcd_barrier(const XcdBarrier& b, bool t0) {
    asm volatile("s_waitcnt vmcnt(0)" ::: "memory");
    __syncthreads();
    if (t0) {
        unsigned* bar = b.bar;
        __builtin_amdgcn_s_waitcnt(0);
        unsigned nloc = b.st[0], nx = b.st[1];
        if (nloc == 0u) { xcd_barrier_complete(bar, b.x, nloc, nx); b.st[0] = nloc; b.st[1] = nx; }
        const unsigned old = xb_add(&bar[XB_XSUB(b.x)], 1u);
        const unsigned gen = old / nloc;
        if (old + 1u == (gen + 1u) * nloc) {
            __builtin_amdgcn_fence(__ATOMIC_RELEASE, "agent");
            asm volatile("s_waitcnt vmcnt(0)" ::: "memory");
            const unsigned og = xb_add(&bar[XB_TOP], 1u);
            const unsigned tg = og / nx;
            if (og + 1u == (tg + 1u) * nx) xb_add(&bar[XB_TOPGEN], 1u);
            else XB_SPIN(xb_ld(&bar[XB_TOPGEN]) == tg, bar);
            __builtin_amdgcn_fence(__ATOMIC_ACQUIRE, "agent");
            xb_add(&bar[XB_XGEN(b.x)], 1u);
            asm volatile("s_waitcnt vmcnt(0)" ::: "memory");
        } else {
            XB_SPIN(xb_ld(&bar[XB_XGEN(b.x)]) == gen, bar);
            __builtin_amdgcn_fence(__ATOMIC_ACQUIRE, "agent");
            asm volatile("s_waitcnt vmcnt(0)" ::: "memory");
        }
    }
    __syncthreads();
}

struct Frame {
    LAS unsigned char* lds;
    volatile LAS unsigned* MISC;
    gu32* ctl;
    int wave;
    int vcu, G;
};
__device__ __forceinline__ int mk_lane() { int l; asm volatile("v_mbcnt_lo_u32_b32 %0, -1, 0\n\tv_mbcnt_hi_u32_b32 %0, -1, %0" : "=v"(l)); return l; }
#define MK_TID(F) ((F).wave * 64 + mk_lane())
__device__ __forceinline__ float wave_sum(float v) {
#pragma unroll
    for (int o = 1; o < 64; o <<= 1) v += __shfl_xor(v, o);
    return v;
}
struct TrItem { const float* W; const float* gk; bf16* WT; int N, ldk, k0, n0, drow0, dk0, f8; };
__device__ __forceinline__ void p0_tr_load(const TrItem& t, int lane, f32x4 (&v)[8]) {
#pragma unroll
    for (int i = 0; i < 8; ++i) v[i] = __builtin_nontemporal_load((const GAS f32x4*)(t.W + (size_t)(t.k0 + 8 * (lane >> 3) + i) * t.N + t.n0 + 4 * (lane & 7)));
}
__device__ __forceinline__ void p0_tr_store(const TrItem& t, const f32x4 (&v)[8], LAS float*, int lane) {
    const int a = lane >> 3, c = lane & 7; float g[8];
    const float sc = t.f8 ? 64.f : 1.f;
    if (t.gk) { const f32x4 g0 = *(const GAS f32x4*)(t.gk + t.k0 + 8 * a), g1 = *(const GAS f32x4*)(t.gk + t.k0 + 8 * a + 4);
        g[0] = g0.x * sc; g[1] = g0.y * sc; g[2] = g0.z * sc; g[3] = g0.w * sc; g[4] = g1.x * sc; g[5] = g1.y * sc; g[6] = g1.z * sc; g[7] = g1.w * sc; }
    else {
#pragma unroll
        for (int i = 0; i < 8; ++i) g[i] = sc; }
#pragma unroll
    for (int q = 0; q < 4; ++q) { float x[8];
#pragma unroll
        for (int i = 0; i < 8; ++i) x[i] = v[i][q] * g[i];
        const int n = 4 * c + q;
        if (t.f8) { v2u o; unsigned lo = 0, hi = 0;
            lo = __builtin_amdgcn_cvt_pk_fp8_f32(x[0], x[1], lo, false); lo = __builtin_amdgcn_cvt_pk_fp8_f32(x[2], x[3], lo, true);
            hi = __builtin_amdgcn_cvt_pk_fp8_f32(x[4], x[5], hi, false); hi = __builtin_amdgcn_cvt_pk_fp8_f32(x[6], x[7], hi, true); o.x = lo; o.y = hi;
            __builtin_nontemporal_store(o, (GAS v2u*)((unsigned char*)t.WT + (size_t)(t.drow0 + n) * t.ldk + t.dk0 + 8 * a)); }
        else { v4u o; o.x = pk2(x[0], x[1]); o.y = pk2(x[2], x[3]); o.z = pk2(x[4], x[5]); o.w = pk2(x[6], x[7]);
            *(GAS v4u*)(t.WT + (size_t)(t.drow0 + n) * t.ldk + t.dk0 + 8 * a) = o; } }
}

struct Ptrs {
    const float *x, *p, *rel_bias, *g_mix, *w_in, *lq1, *lk1, *lq2, *lk2, *subg, *s_lre, *s_lim, *s_ldt, *s_bre, *s_bim, *s_cre, *s_cim, *s_d, *w_glu, *b_glu, *g_ssm, *w_o, *g_ffn,
                *w_rg, *b_rg, *w_re, *b_re, *w1, *w3, *w2, *g_ple, *w_pg, *w_pp, *g_final;
    float* out; unsigned char* ws;
};

__device__ __forceinline__ void p0_ssm_group(const Frame& F, const Ptrs& P, int g, int qd) {
    LAS float* L = (LAS float*)(F.lds + RING_OFF);
    LAS float* pw = L;
    LAS float* bbr = L + 2304;
    LAS float* bbi = bbr + 1024;
    LAS float* cre = bbi + 1024;
    LAS float* cim = cre + 1024;
    LAS float* Kt = cim + 1024;
    LAS float* dd = Kt + 4096;
    const int tid = MK_TID(F);
    if (tid < 64) {
        const int p = tid;
        const float lre = P.s_lre[g * 64 + p], lim = P.s_lim[g * 64 + p], dt = expf(P.s_ldt[g]);
        const float mag = expf(lre * dt), ar = mag * cosf(lim * dt), ai = mag * sinf(lim * dt);
        const float den = lre * lre + lim * lim, nr = ar - 1.f, ni = ai;
        const float cr = (nr * lre + ni * lim) / den, ci = (ni * lre - nr * lim) / den;
        float gr = 1.f, gi = 0.f;
        for (int n = 0; n <= 16; ++n) { pw[(n * 64 + p) * 2] = gr; pw[(n * 64 + p) * 2 + 1] = gi; const float t = gr * ar - gi * ai; gi = gr * ai + gi * ar; gr = t; }
        float a16r = pw[(16 * 64 + p) * 2], a16i = pw[(16 * 64 + p) * 2 + 1], qr = a16r, qi = a16i;
        for (int s = 0; s < 5; ++s) { const float t = qr * qr - qi * qi; qi = 2.f * qr * qi; qr = t; }
        if (qd == 0) { float* sc = (float*)(P.ws + WS_SSC) + (g * 64 + p) * 4; sc[0] = a16r; sc[1] = a16i; sc[2] = qr; sc[3] = qi; }
        for (int h = 0; h < 16; ++h) { const float br = P.s_bre[(g * 64 + p) * 16 + h], bi = P.s_bim[(g * 64 + p) * 16 + h]; bbr[p * 16 + h] = cr * br - ci * bi; bbi[p * 16 + h] = cr * bi + ci * br; }
    }
    for (int i = tid; i < 1024; i += NWAVES * 64) { cre[i] = P.s_cre[g * 1024 + i]; cim[i] = P.s_cim[g * 1024 + i]; }
    if (tid < 16) dd[tid] = P.s_d[g * 16 + tid];
    __syncthreads();
    {
        const int h = (tid >> 4) & 15, h2 = tid & 15, t0 = tid >> 8; float acc[8];
#pragma unroll
        for (int k = 0; k < 8; ++k) acc[k] = 0.f;
        for (int p = 0; p < 64; ++p) { const float c1 = cre[h * 64 + p], c2 = cim[h * 64 + p], br = bbr[p * 16 + h2], bi = bbi[p * 16 + h2];
            const float X = c1 * br - c2 * bi, Y = c1 * bi + c2 * br;
#pragma unroll
            for (int k = 0; k < 8; ++k) { const int tau = t0 + 2 * k; acc[k] += pw[(tau * 64 + p) * 2] * X - pw[(tau * 64 + p) * 2 + 1] * Y; } }
#pragma unroll
        for (int k = 0; k < 8; ++k) Kt[((t0 + 2 * k) << 8) + (h << 4) + h2] = acc[k];
    }
    __syncthreads();
    bf16* TV = (bf16*)(P.ws + WS_TVT) + (size_t)g * 256 * 384;
    for (int it = tid; it < 64 * 48; it += NWAVES * 64) {
        const int n = 64 * qd + it / 48, k0 = (it % 48) * 8, i = n >> 4, h = n & 15; float v[8];
#pragma unroll
        for (int q = 0; q < 8; ++q) { const int k = k0 + q;
            if (k < 256) { const int j = k >> 4, h2 = k & 15; float t = (j <= i) ? Kt[((i - j) * 16 + h) * 16 + h2] : 0.f; if (j == i && h2 == h) t += dd[h]; v[q] = t; }
            else { const int p = (k - 256) & 63, part = (k - 256) >> 6; const float gr = pw[((i + 1) * 64 + p) * 2], gi = pw[((i + 1) * 64 + p) * 2 + 1], c1 = cre[h * 64 + p], c2 = cim[h * 64 + p];
                   v[q] = part == 0 ? (c1 * gr - c2 * gi) : (-c1 * gi - c2 * gr); } }
        v4u o; o.x = pk2(v[0], v[1]); o.y = pk2(v[2], v[3]); o.z = pk2(v[4], v[5]); o.w = pk2(v[6], v[7]);
        *(GAS v4u*)(TV + (size_t)n * 384 + k0) = o;
    }
    bf16* W1 = (bf16*)(P.ws + WS_W1T) + (size_t)g * 256 * 256;
    for (int it = tid; it < 64 * 32; it += NWAVES * 64) {
        const int n = 64 * qd + (it >> 5), k0 = (it & 31) * 8; float v[8];
#pragma unroll
        for (int q = 0; q < 8; ++q) { const int k = k0 + q, j = k >> 4, h2 = k & 15;
            if (n < 128) { const int p = n & 63; const float gr = pw[((15 - j) * 64 + p) * 2], gi = pw[((15 - j) * 64 + p) * 2 + 1], br = bbr[p * 16 + h2], bi = bbi[p * 16 + h2];
                           v[q] = n < 64 ? (gr * br - gi * bi) : (gr * bi + gi * br); }
            else v[q] = 0.f; }
        v4u o; o.x = pk2(v[0], v[1]); o.y = pk2(v[2], v[3]); o.z = pk2(v[4], v[5]); o.w = pk2(v[6], v[7]);
        *(GAS v4u*)(W1 + (size_t)n * 256 + k0) = o;
    }
    __syncthreads();
}

constexpr int P0_ITEMS_EARLY = 16 * 128 + 8 * 32;
constexpr int P0_ITEMS_ALL = 16 * 128 + 8 * 32 + 16 * 64 + 2 * NE * 16 * 16 + NE * 4 * 64 + 16 * 64 + 2 * 64;
__device__ __forceinline__ void p0_weights(const Frame& F, const Ptrs& P, int it0, int it1) {
    unsigned char* ws = P.ws;
    LAS float* scr = (LAS float*)(F.lds + RING_OFF + F.wave * 16384);
    const int gw = F.vcu * NWAVES + F.wave, NGW = F.G * NWAVES, lane = mk_lane();
    constexpr int I_IN = 16 * 128, I_GLU = 8 * 32, I_O = 16 * 64, I_13 = 2 * NE * 16 * 16, I_2 = NE * 4 * 64, I_PG = 16 * 64, I_PP = 2 * 64;
    constexpr int NITEMS = I_IN + I_GLU + I_O + I_13 + I_2 + I_PG + I_PP;
#define P0_DECODE(T, IT, HF) do { int r = (IT); T.f8 = 0; \
        if (r < I_IN) { const int kb = 2 * (r / 128) + (HF), nb = r % 128; T.W = P.w_in; T.N = 4096; T.gk = P.g_mix; T.WT = (bf16*)(ws + WS_WIN); T.ldk = 2048; T.k0 = 64 * kb; T.n0 = 32 * nb; T.drow0 = 32 * nb; T.dk0 = 64 * kb; break; } r -= I_IN; \
        if (r < I_GLU) { const int kb = 2 * (r / 32) + (HF), nb = r % 32; T.W = P.w_glu; T.N = 1024; T.gk = nullptr; T.WT = (bf16*)(ws + WS_WGLU); T.ldk = 1024; T.k0 = 64 * kb; T.n0 = 32 * nb; T.drow0 = 32 * nb; T.dk0 = 64 * kb; break; } r -= I_GLU; \
        if (r < I_O) { const int kb = 2 * (r / 64) + (HF), nb = r % 64; T.W = P.w_o; T.N = 2048; T.gk = (kb >= 16) ? (P.g_ssm - 1024) : nullptr; T.WT = (bf16*)(ws + WS_WO); T.ldk = 2048; T.k0 = 64 * kb; T.n0 = 32 * nb; T.drow0 = 32 * nb; T.dk0 = (64 * kb + 1024) & 2047; break; } r -= I_O; \
        if (r < I_13) { const int e = r / 512, q = r % 512, mat = q >> 8, kb = 2 * ((q & 255) / 16) + (HF), nb = q & 15, n0 = 32 * nb; T.W = (mat ? P.w3 : P.w1) + (size_t)e * 2048 * 512; T.N = 512; T.gk = P.g_ffn; \
            T.WT = (bf16*)(ws + WS_W13 + (size_t)e * 1024 * 2048); T.f8 = 1; T.ldk = 2048; T.k0 = 64 * kb; T.n0 = n0; T.drow0 = (n0 >> 7) * 256 + mat * 128 + (n0 & 127); T.dk0 = 64 * kb; break; } r -= I_13; \
        if (r < I_2) { const int e = r / 256, q = r % 256, kb = 2 * (q / 64) + (HF), nb = q % 64; T.W = P.w2 + (size_t)e * 512 * 2048; T.N = 2048; T.gk = nullptr; T.WT = (bf16*)(ws + WS_W2 + (size_t)e * 2048 * 512); T.f8 = 1; T.ldk = 512; \
            T.k0 = 64 * kb; T.n0 = 32 * nb; T.drow0 = 32 * nb; T.dk0 = 64 * kb; break; } r -= I_2; \
        if (r < I_PG) { const int kb = 2 * (r / 64) + (HF), nb = r % 64; T.W = P.w_pg; T.N = 2048; T.gk = P.g_ple; T.WT = (bf16*)(ws + WS_WPG); T.f8 = 1; T.ldk = 2048; T.k0 = 64 * kb; T.n0 = 32 * nb; T.drow0 = 32 * nb; T.dk0 = 64 * kb; break; } r -= I_PG; \
        { const int kb = 2 * (r / 64) + (HF), nb = r % 64; T.W = P.w_pp; T.N = 2048; T.gk = nullptr; T.WT = (bf16*)(ws + WS_WPP); T.ldk = 256; T.k0 = 64 * kb; T.n0 = 32 * nb; T.drow0 = 32 * nb; T.dk0 = 64 * kb; } } while (0)
    for (int it = it0 + gw; it < it1; it += NGW) {
        TrItem t0, t1; f32x4 v0[8], v1[8];
        P0_DECODE(t0, it, 0); p0_tr_load(t0, lane, v0);
        P0_DECODE(t1, it, 1); p0_tr_load(t1, lane, v1);
        p0_tr_store(t0, v0, scr, lane);
        p0_tr_store(t1, v1, scr, lane);
    }
#undef P0_DECODE
}
__device__ __forceinline__ void p0_prologue(const Frame& F, const Ptrs& P) {
    unsigned char* ws = P.ws;
    for (int gi = F.vcu; gi < 256; gi += F.G) p0_ssm_group(F, P, gi >> 2, gi & 3);
    const int gw = F.vcu * NWAVES + F.wave, NGW = F.G * NWAVES, lane = mk_lane();
    p0_weights(F, P, 0, P0_ITEMS_EARLY);
    for (int m = gw; m < M; m += 2 * NGW) {
        const int m1 = m + NGW;
        const GAS f32x4* xr = (const GAS f32x4*)(P.x + (size_t)m * D) + lane; const GAS f32x4* xr1 = (const GAS f32x4*)(P.x + (size_t)(m1 < M ? m1 : m) * D) + lane;
        f32x4 v[8], u[8]; float s = 0.f, s1 = 0.f;
#pragma unroll
        for (int j = 0; j < 8; ++j) { v[j] = __builtin_nontemporal_load(xr + 64 * j); u[j] = __builtin_nontemporal_load(xr1 + 64 * j); }
#pragma unroll
        for (int j = 0; j < 8; ++j) { s += (v[j].x * v[j].x + v[j].y * v[j].y) + (v[j].z * v[j].z + v[j].w * v[j].w); s1 += (u[j].x * u[j].x + u[j].y * u[j].y) + (u[j].z * u[j].z + u[j].w * u[j].w); }
        s = wave_sum(s); s1 = wave_sum(s1);
        if (lane == 0) { ((float*)(ws + WS_R0))[m] = 1.0f / sqrtf(s * (1.f / D) + EPS); if (m1 < M) ((float*)(ws + WS_R0))[m1] = 1.0f / sqrtf(s1 * (1.f / D) + EPS); }
        GAS v2u* o8 = (GAS v2u*)((bf16*)(ws + WS_A) + (size_t)m * D) + lane;
#pragma unroll
        for (int j = 0; j < 8; ++j) { v2u o; o.x = pk2(v[j].x, v[j].y); o.y = pk2(v[j].z, v[j].w); o8[64 * j] = o; }
        if (m1 < M) { GAS v2u* o9 = (GAS v2u*)((bf16*)(ws + WS_A) + (size_t)m1 * D) + lane;
#pragma unroll
            for (int j = 0; j < 8; ++j) { v2u o; o.x = pk2(u[j].x, u[j].y); o.y = pk2(u[j].z, u[j].w); o9[64 * j] = o; } }
    }
    { const int gt = (F.vcu * NWAVES + F.wave) * 64 + lane, NT = F.G * NWAVES * 64;
      for (int i = gt; i < M * PLE / 4; i += 4 * NT) { f32x4 v[4];
#pragma unroll
          for (int q = 0; q < 4; ++q) { const int ii = i + q * NT; v[q] = ((const GAS f32x4*)P.p)[ii < M * PLE / 4 ? ii : i]; }
#pragma unroll
          for (int q = 0; q < 4; ++q) { const int ii = i + q * NT; if (ii < M * PLE / 4) { v2u o; o.x = pk2(v[q].x, v[q].y); o.y = pk2(v[q].z, v[q].w); ((GAS v2u*)(ws + WS_PBF))[ii] = o; } } }
      for (int i = gt; i < 64 * 2048; i += NT) { const int j = i >> 11, k = i & 2047; float v = 0.f;
          if (j < 4) v = P.w_rg[k * 4 + j] * P.g_ffn[k]; else if (j < 36) v = P.w_re[k * 32 + (j - 4)] * P.g_ffn[k];
          ((bf16*)(ws + WS_WR))[i] = (bf16)f2bf(v); }
      if (gt < 64) { const float lam = __expf(wave_sum(P.lq1[lane] * P.lk1[lane])) - __expf(wave_sum(P.lq2[lane] * P.lk2[lane])) + 0.2f; if (gt == 0) *(float*)(ws + WS_NLAM) = -lam; }
      for (int i = gt; i < 8 * 384; i += NT) { const int h = i / 384, n = i % 384 - 127; int bucket = 31;
          if (n >= 0 && n < 16) bucket = n; else if (n >= 16 && n < 128) { const int lg = 16 + (int)(logf((float)n / 16.f) / 2.0794415416798357f * 16.f); bucket = lg < 31 ? lg : 31; }
          ((float*)(ws + WS_LUT))[i] = (P.rel_bias[bucket * 8 + h] - P.rel_bias[31 * 8 + h]) * 1.4426950408889634f; }
    }
}

__device__ __forceinline__ void ssm_scan(const Frame& F, const Ptrs& P, int g, bf16* item) {
    const LAS float* E = (const LAS float*)(F.lds + RING_OFF);
    LAS float* S = (LAS float*)(F.lds + XTRA_OFF);
    const int p = mk_lane(), w = F.wave, c0 = 32 * w;
    const f32x4 sc = *(const f32x4*)((const float*)(P.ws + WS_SSC) + (g * 64 + p) * 4);
    float xr = 0.f, xi = 0.f;
#pragma unroll 8
    for (int c = c0; c < c0 + 32; ++c) { const float er = E[c * 128 + p], ei = E[c * 128 + 64 + p]; const float t = sc.x * xr - sc.y * xi + er; xi = sc.x * xi + sc.y * xr + ei; xr = t; }
    S[(w * 64 + p) * 2] = xr; S[(w * 64 + p) * 2 + 1] = xi;
    __syncthreads();
    xr = 0.f; xi = 0.f;
    for (int w2 = 0; w2 < w; ++w2) { const float t = sc.z * xr - sc.w * xi + S[(w2 * 64 + p) * 2]; xi = sc.z * xi + sc.w * xr + S[(w2 * 64 + p) * 2 + 1]; xr = t; }
#pragma unroll 8
    for (int c = c0; c < c0 + 32; ++c) {
        bf16* row = item + (size_t)c * 384 + 256; row[p] = (bf16)f2bf(xr); row[64 + p] = (bf16)f2bf(xi);
        const float er = E[c * 128 + p], ei = E[c * 128 + 64 + p]; const float t = sc.x * xr - sc.y * xi + er; xi = sc.x * xi + sc.y * xr + ei; xr = t; }
    VM_WAIT(); __syncthreads();
}
struct OneUnit { pg8::Unit u; __device__ __forceinline__ bool next(int i, pg8::Unit& o) const { if (i > 0) return false; o = u; return true; } };

__device__ __forceinline__ void p6_router(const Frame& F, const Ptrs& P) {
    const int lane = mk_lane(), w = F.wave, th = w & 1, kq = w >> 1, r32 = lane & 31, hi = lane >> 5, rtid = w * 64 + lane;
    const bf16* x1b = (const bf16*)(P.ws + WS_A); const bf16* WrT = (const bf16*)(P.ws + WS_WR);
    LAS float* red = (LAS float*)(F.lds + RING_OFF);
    LAS int* lcnt = (LAS int*)(F.lds + XTRA_OFF);
    int* cnt = (int*)(F.ctl + CW_CNT);
    int* row_ts = (int*)(P.ws + WS_RTS); float* row_w = (float*)(P.ws + WS_RW); float* row_r = (float*)(P.ws + WS_RR);
    const float* ssq1 = (const float*)(P.ws + WS_SSQ1);
    for (int blk = F.vcu; blk < M / 64; blk += F.G) {
        const int T0 = blk * 64;
        if (rtid < 64) lcnt[rtid] = 0;
        f32x16 acc0 = {}, acc1 = {};
        const bf16* ap = x1b + (size_t)(T0 + 32 * th + r32) * 2048 + kq * 512 + 8 * hi;
        const bf16* bp0 = WrT + (size_t)r32 * 2048 + kq * 512 + 8 * hi; const bf16* bp1 = bp0 + 32 * 2048;
#pragma unroll 4
        for (int ks = 0; ks < 32; ++ks) {
            const bf16x8 a = *(const GAS bf16x8*)(ap + ks * 16), b0 = *(const GAS bf16x8*)(bp0 + ks * 16), b1 = *(const GAS bf16x8*)(bp1 + ks * 16);
            acc0 = __builtin_amdgcn_mfma_f32_32x32x16_bf16(a, b0, acc0, 0, 0, 0); acc1 = __builtin_amdgcn_mfma_f32_32x32x16_bf16(a, b1, acc1, 0, 0, 0);
        }
#pragma unroll
        for (int r = 0; r < 16; ++r) { const int tk = 32 * th + (r & 3) + 8 * (r >> 2) + 4 * hi; red[(kq * 64 + tk) * 64 + r32] = acc0[r]; red[(kq * 64 + tk) * 64 + 32 + r32] = acc1[r]; }
        __syncthreads();
        int e0 = 0, e1 = 0, lp0 = 0, lp1 = 0; float w0 = 0.f, w1 = 0.f, r1 = 0.f;
        if (rtid < 64) {
            const int tok = T0 + rtid; float ss = 0.f;
            for (int i = 0; i < 32; ++i) ss += ssq1[(size_t)tok * 32 + i];
            r1 = 1.0f / sqrtf(ss * (1.f / D) + EPS);
            float lg[4];
#pragma unroll
            for (int j = 0; j < 4; ++j) lg[j] = (red[(0 * 64 + rtid) * 64 + j] + red[(1 * 64 + rtid) * 64 + j] + red[(2 * 64 + rtid) * 64 + j] + red[(3 * 64 + rtid) * 64 + j]) * r1 + P.b_rg[j];
            int gs = 0; float lm = lg[0];
            if (lg[1] > lm) { lm = lg[1]; gs = 1; } if (lg[2] > lm) { lm = lg[2]; gs = 2; } if (lg[3] > lm) { lm = lg[3]; gs = 3; }
            const float gate_g = 1.0f / (__expf(lg[0] - lm) + __expf(lg[1] - lm) + __expf(lg[2] - lm) + __expf(lg[3] - lm));
            float m0 = -3.0e38f, m1 = -3.0e38f; int i0 = 0, i1 = 0;
            for (int j = 0; j < 8; ++j) { const int c = 4 + gs * 8 + j;
                const float le = (red[(0 * 64 + rtid) * 64 + c] + red[(1 * 64 + rtid) * 64 + c] + red[(2 * 64 + rtid) * 64 + c] + red[(3 * 64 + rtid) * 64 + c]) * r1 + P.b_re[gs * 8 + j];
                if (le > m0) { m1 = m0; i1 = i0; m0 = le; i0 = j; } else if (le > m1) { m1 = le; i1 = j; } }
            const float p1 = __expf(m1 - m0);
            w0 = gate_g / (1.f + p1); w1 = gate_g * p1 / (1.f + p1); e0 = gs * 8 + i0; e1 = gs * 8 + i1;
            lp0 = atomicAdd((int*)&lcnt[e0], 1); lp1 = atomicAdd((int*)&lcnt[e1], 1);
        }
        __syncthreads();
        if (rtid < 32) { const int n = lcnt[rtid]; lcnt[32 + rtid] = n ? atomicAdd(&cnt[rtid], n) : 0; }
        __syncthreads();
        if (rtid < 64) { const int tok = T0 + rtid;
            const int i0 = e0 * ECAP + lcnt[32 + e0] + lp0, i1 = e1 * ECAP + lcnt[32 + e1] + lp1;
            row_ts[i0] = tok * 2; row_w[i0] = w0; row_r[i0] = r1; row_ts[i1] = tok * 2 + 1; row_w[i1] = w1; row_r[i1] = r1; }
        __syncthreads();
    }
}

template <int NTN, bool UP>
struct MoeOrder {
    const LAS int* pre;
    const char* A; const char* B; const int* row_ts; const int* cnt; int G, c;
    __device__ __forceinline__ bool next(int i, pg8::Unit& u) const {
        const int L = i * G + c, TT = pre[32]; if (L >= TT * NTN) return false;
        const int ti = L / NTN, nt = L % NTN; int e = 0;
        for (int q = 1; q < 32; ++q) e += (ti >= pre[q]) ? 1 : 0;
        const int mt = ti - pre[e];
        u.pm = ti; u.pn = nt; u.x0 = e * ECAP + mt * 256;
        if (UP) { u.A = A; u.B = B + ((size_t)e * 1024 + (size_t)nt * 256) * 2048; u.rows = row_ts + u.x0; u.x1 = ti; }
        else { u.A = A + (size_t)ti * 256 * 512; u.B = B + ((size_t)e * 2048 + (size_t)nt * 256) * 512; u.rows = nullptr; const int left = cnt[e] - mt * 256; u.x1 = left < 256 ? left : 256; }
        if (UP) { const int left = cnt[e] - mt * 256; u.pn = nt; u.pm = left < 256 ? left : 256; }
        return true;
    }
    __device__ __forceinline__ int arow(const pg8::Unit& u, int r) const { if (!UP) return r; return r < u.pm ? (u.rows[r] >> 1) : 0; }
};
__device__ __forceinline__ void moe_prefix(const Frame& F) {
    LAS int* pre = (LAS int*)(F.lds + XTRA_OFF + 1024);
    __syncthreads();
    if (MK_TID(F) == 0) { int s = 0; for (int e = 0; e < 32; ++e) { pre[e] = s; s += ((int)__hip_atomic_load(F.ctl + CW_CNT + e, RLX_AGENT) + 255) >> 8; } pre[32] = s; }
    __syncthreads();
}

__device__ __forceinline__ void p9_combine(const Frame& F, const Ptrs& P) {
    const int lane = mk_lane(), gw = F.vcu * NWAVES + F.wave, NGW = F.G * NWAVES;
    const bf16* x1b = (const bf16*)(P.ws + WS_A); const unsigned char* c0 = (const unsigned char*)P.out; const unsigned char* c1 = c0 + (size_t)M * 2048; bf16* x2b = (bf16*)(P.ws + WS_B); unsigned char* x2f8 = P.ws + WS_X2F8;
    for (int m = gw; m < M; m += NGW) { float q = 0.f; v4u o[4]; v2u o8[4];
#pragma unroll
        for (int j = 0; j < 4; ++j) { const size_t off = (size_t)m * 2048 + (size_t)(j * 64 + lane) * 8;
            const v4u a = __builtin_nontemporal_load((const GAS v4u*)(x1b + off)); const v2u b = __builtin_nontemporal_load((const GAS v2u*)(c0 + off)), c = __builtin_nontemporal_load((const GAS v2u*)(c1 + off));
            float f[8];
#pragma unroll
            for (int i = 0; i < 4; ++i) { const unsigned bw = (i < 2) ? b.x : b.y, cw = (i < 2) ? c.x : c.y;
                const pg8::f32x2 bb = (i & 1) ? __builtin_amdgcn_cvt_pk_f32_fp8(bw, true) : __builtin_amdgcn_cvt_pk_f32_fp8(bw, false), cc = (i & 1) ? __builtin_amdgcn_cvt_pk_f32_fp8(cw, true) : __builtin_amdgcn_cvt_pk_f32_fp8(cw, false);
                const float lo = bflo(a[i]) + (bb[0] + cc[0]) * 0.03125f, hi = bfhi(a[i]) + (bb[1] + cc[1]) * 0.03125f; q += lo * lo + hi * hi; o[j][i] = pk2(lo, hi); f[2 * i] = lo; f[2 * i + 1] = hi; }
            { unsigned w0 = 0, w1 = 0; w0 = __builtin_amdgcn_cvt_pk_fp8_f32(f[0], f[1], w0, false); w0 = __builtin_amdgcn_cvt_pk_fp8_f32(f[2], f[3], w0, true);
              w1 = __builtin_amdgcn_cvt_pk_fp8_f32(f[4], f[5], w1, false); w1 = __builtin_amdgcn_cvt_pk_fp8_f32(f[6], f[7], w1, true); o8[j].x = w0; o8[j].y = w1; } }
        q = wave_sum(q);
        if (lane == 0) ((float*)(P.ws + WS_R2))[m] = 1.0f / sqrtf(q * (1.f / D) + EPS);
#pragma unroll
        for (int j = 0; j < 4; ++j) { *(GAS v4u*)(x2b + (size_t)m * 2048 + (size_t)(j * 64 + lane) * 8) = o[j]; *(GAS v2u*)(x2f8 + (size_t)m * 2048 + (size_t)(j * 64 + lane) * 8) = o8[j]; }
    }
}
__device__ __forceinline__ void p11_final(const Frame& F, const Ptrs& P) {
    const int lane = mk_lane(), gw = F.vcu * NWAVES + F.wave, NGW = F.G * NWAVES;
    const bf16* x3b = (const bf16*)(P.ws + WS_B2); const float* ssq3 = (const float*)(P.ws + WS_SSQ3);
    for (int m = gw; m < M; m += NGW) {
        const float r3 = 1.0f / sqrtf(wave_sum(lane < 32 ? ssq3[(size_t)m * 32 + lane] : 0.f) * (1.f / D) + EPS);
#pragma unroll
        for (int j = 0; j < 4; ++j) { const size_t col = (size_t)(j * 64 + lane) * 8; const v4u a = __builtin_nontemporal_load((const GAS v4u*)(x3b + (size_t)m * 2048 + col));
            const f32x4 g0 = *(const GAS f32x4*)(P.g_final + col), g1 = *(const GAS f32x4*)(P.g_final + col + 4);
            f32x4 o0, o1; o0.x = bflo(a.x) * r3 * g0.x; o0.y = bfhi(a.x) * r3 * g0.y; o0.z = bflo(a.y) * r3 * g0.z; o0.w = bfhi(a.y) * r3 * g0.w;
            o1.x = bflo(a.z) * r3 * g1.x; o1.y = bfhi(a.z) * r3 * g1.y; o1.z = bflo(a.w) * r3 * g1.z; o1.w = bfhi(a.w) * r3 * g1.w;
            *(GAS f32x4*)(P.out + (size_t)m * 2048 + col) = o0; *(GAS f32x4*)(P.out + (size_t)m * 2048 + col + 4) = o1; }
    }
}

struct Args { const float* in[34]; float* out; unsigned char* ws; int ph_lo, ph_hi, li, pad; };
__global__ void __launch_bounds__(NWAVES * 64, 2) mk_fwd(Args args) {
    extern __shared__ __attribute__((aligned(16))) unsigned char lds[];
    Frame F;
    F.lds = (LAS unsigned char*)lds;
    F.MISC = (volatile LAS unsigned*)(F.lds + MISC_OFF);
    F.wave = __builtin_amdgcn_readfirstlane((int)threadIdx.x >> 6);
    F.G = gridDim.x; { const int bx = blockIdx.x; F.vcu = (F.G % 8 == 0) ? (bx % 8) * (F.G / 8) + bx / 8 : bx; }
    Ptrs P;
    P.x = args.in[0]; P.p = args.in[1]; P.rel_bias = args.in[2]; P.g_mix = args.in[3]; P.w_in = args.in[4]; P.lq1 = args.in[5]; P.lk1 = args.in[6]; P.lq2 = args.in[7]; P.lk2 = args.in[8]; P.subg = args.in[9];
    P.s_lre = args.in[10]; P.s_lim = args.in[11]; P.s_ldt = args.in[12]; P.s_bre = args.in[13]; P.s_bim = args.in[14]; P.s_cre = args.in[15]; P.s_cim = args.in[16]; P.s_d = args.in[17];
    P.w_glu = args.in[18]; P.b_glu = args.in[19]; P.g_ssm = args.in[20]; P.w_o = args.in[21]; P.g_ffn = args.in[22]; P.w_rg = args.in[23]; P.b_rg = args.in[24]; P.w_re = args.in[25]; P.b_re = args.in[26];
    P.w1 = args.in[27]; P.w3 = args.in[28]; P.w2 = args.in[29]; P.g_ple = args.in[30]; P.w_pg = args.in[31]; P.w_pp = args.in[32]; P.g_final = args.in[33];
    P.out = args.out; P.ws = args.ws;
    unsigned char* ws = args.ws;
    F.ctl = (gu32*)(ws + WS_CTL);
    for (int u = MK_TID(F); u < (LDS_BYTES - LDSCTL_OFF) / 4; u += NWAVES * 64) ((LAS unsigned*)(F.lds + LDSCTL_OFF))[u] = 0u;
    __syncthreads();
    XcdBarrier bar; bar.bar = (unsigned*)(F.ctl + CW_BAR); bar.x = 0; bar.st = nullptr;
    if (MK_ONE_LAUNCH) bar = xcd_barrier_post((unsigned*)(F.ctl + CW_BAR), F.MISC + 8, MK_TID(F) == 0);
#define GRID_BAR() do { if (MK_ONE_LAUNCH) xcd_barrier(bar, MK_TID(F) == 0); } while (0)
    const int lo = args.ph_lo, hi = args.ph_hi;
#ifndef ONLY_PH
#define ONLY_PH -1
#endif
#define IN(k) ((ONLY_PH == -1 || ONLY_PH == (k)) && lo <= (k) && (k) < hi)
#define BOTH(k) (IN(k) && IN((k) + 1))
    bf16* Qb = (bf16*)P.out; bf16* Kb = Qb + (size_t)M * 1024; bf16* Vb = Kb + (size_t)M * 1024; bf16* s1b = Vb + (size_t)M * 1024;
    bf16* Ue = (bf16*)(ws + WS_B);

    if (IN(0)) { p0_prologue(F, P); if (BOTH(0)) GRID_BAR(); }

    if (IN(1)) {
        pg8::DenseOrder S; S.init(ws + WS_A, ws + WS_WIN, 2048, 2048, M, 4096, F.G, (int)blockIdx.x);
        pg8::EpiZ E; E.Q = Qb; E.Ue = Ue; E.r0 = (const float*)(ws + WS_R0); E.c2 = attn_body::C2;
        pg8::gemm_phase<pg8::EpiZ, pg8::DenseOrder, true, false>(F.lds + RING_OFF, F.wave, 2048, 2048, 2048, S, E);
        if (BOTH(1)) GRID_BAR();
    }
    if (IN(2)) {
#ifndef SKIP_SSM
        for (int item = F.vcu; item < 256; item += F.G) {
            const int g = item >> 2, b = item & 3;
            bf16* itA = Ue + (size_t)item * 256 * 384;
            OneUnit S1; S1.u.A = (const char*)itA; S1.u.B = (const char*)((bf16*)(ws + WS_W1T) + (size_t)g * 256 * 256); S1.u.rows = nullptr; S1.u.pm = 0; S1.u.pn = 0; S1.u.x0 = g; S1.u.x1 = b;
            pg8::EpiE E1;
            pg8::gemm_phase<pg8::EpiE, OneUnit, false, false>(F.lds + RING_OFF, F.wave, 256, 384, 256, S1, E1);
            __syncthreads();
            ssm_scan(F, P, g, itA);
            OneUnit S2; S2.u = S1.u; S2.u.B = (const char*)((bf16*)(ws + WS_TVT) + (size_t)g * 256 * 384);
            pg8::EpiY E2; E2.s1 = s1b;
            pg8::gemm_phase<pg8::EpiY, OneUnit, false, false>(F.lds + RING_OFF, F.wave, 384, 384, 384, S2, E2);
            __syncthreads();
        }
#endif
#ifndef SKIP_ATTN
        const attn_body::AttnTensors AT{(const attn_body::bf16*)Qb, (const attn_body::bf16*)Kb, (const attn_body::bf16*)Vb, (attn_body::bf16*)(ws + WS_B2), (const float*)(ws + WS_LUT), P.subg, (const float*)(ws + WS_NLAM)};
        const attn_body::StaticOrder S((int)F.G, (int)blockIdx.x);
        const int cpos = (F.vcu & 3) == 0 ? 0 : (F.vcu & 3) + 1;
        auto hook = [&](int i) { if (i == cpos) { p0_weights(F, P, P0_ITEMS_EARLY, P0_ITEMS_ALL); asm volatile("s_waitcnt vmcnt(0) lgkmcnt(0)" ::: "memory"); __syncthreads(); } };
        attn_body::attn_phase<attn_body::StaticOrder>((char*)lds + RING_OFF, AT, S, F.wave, hook);
#endif
        if (BOTH(2)) GRID_BAR();
    }
    if (IN(3)) {
        pg8::DenseOrder S; S.init(s1b, ws + WS_WGLU, 1024, 1024, M, 1024, F.G, (int)blockIdx.x);
        pg8::EpiGlu E; E.s1 = s1b; E.bias = P.b_glu; E.scat = (bf16*)(ws + WS_B2); E.ssq = (float*)(ws + WS_SSQ3);
        pg8::gemm_phase<pg8::EpiGlu, pg8::DenseOrder, true, false>(F.lds + RING_OFF, F.wave, 1024, 1024, 1024, S, E);
        if (IN(3) && IN(5)) GRID_BAR();
    }
    if (IN(5)) {
        pg8::DenseOrder S; S.init(ws + WS_B2, ws + WS_WO, 2048, 2048, M, 2048, F.G, (int)blockIdx.x);
        LAS float* rsT = (LAS float*)(F.lds + XTRA_OFF);
        { const int tid = MK_TID(F); const float* sp = (const float*)(ws + WS_SSQ3);
          for (int k = tid >> 8; k < 8; k += 2) { pg8::Unit u; if (!S.next(k, u)) break;
              const f32x4* q4 = (const f32x4*)(sp + (size_t)(u.pm * 256 + (tid & 255)) * 16); const f32x4 a = q4[0], b = q4[1], c = q4[2], d = q4[3];
              const float ss = ((a.x + a.y) + (a.z + a.w)) + ((b.x + b.y) + (b.z + b.w)) + ((c.x + c.y) + (c.z + c.w)) + ((d.x + d.y) + (d.z + d.w));
              rsT[k * 256 + (tid & 255)] = 1.0f / sqrtf(ss * (1.f / 1024.f) + EPS); }
          __syncthreads(); }
        pg8::EpiRes1 E; E.x = P.x; E.x1b = (bf16*)(ws + WS_A); E.x1f8 = ws + WS_X1F8; E.ssq = (float*)(ws + WS_SSQ1); E.rsT = rsT;
        pg8::gemm_phase<pg8::EpiRes1, pg8::DenseOrder, true, false>(F.lds + RING_OFF, F.wave, 2048, 2048, 2048, S, E);
        if (BOTH(5)) GRID_BAR();
    }
    if (IN(6)) {
        p6_router(F, P);
        if (BOTH(6)) GRID_BAR();
    }
    if (IN(7)) {
        moe_prefix(F);
        MoeOrder<4, true> S; S.pre = (const LAS int*)(F.lds + XTRA_OFF + 1024); S.A = (const char*)(ws + WS_X1F8); S.B = (const char*)(ws + WS_W13); S.row_ts = (const int*)(ws + WS_RTS); S.cnt = (const int*)(F.ctl + CW_CNT); S.G = F.G; S.c = F.vcu;
        pg8::EpiUp E; E.row_r = (const float*)(ws + WS_RR); E.hmid = ws + WS_B2;
        pg8::gemm_phase<pg8::EpiUp, MoeOrder<4, true>, true, true, true>(F.lds + RING_OFF, F.wave, 2048, 2048, 2048, S, E);
        {
          const int NU = S.pre[32] * 4, Rr = (NU + F.G - 1) / F.G, first_short = NU - (Rr - 1) * F.G; int Gp = F.G - first_short, rank = F.vcu - first_short;
          if (NU == 0 || Gp < 64) { Gp = F.G; rank = F.vcu; }
          if (rank >= 0) { pg8::DenseOrder Sp; Sp.init(ws + WS_PBF, ws + WS_WPP, 256, 256, M, 2048, Gp, rank);
              pg8::EpiPP Ep; Ep.pp = ws + WS_PP;
              pg8::gemm_phase<pg8::EpiPP, pg8::DenseOrder, true, false>(F.lds + RING_OFF, F.wave, 256, 256, 256, Sp, Ep); } }
        if (BOTH(7)) GRID_BAR();
    }
    if (IN(8)) {
        moe_prefix(F);
        MoeOrder<8, false> S; S.pre = (const LAS int*)(F.lds + XTRA_OFF + 1024); S.A = (const char*)(ws + WS_B2); S.B = (const char*)(ws + WS_W2); S.row_ts = (const int*)(ws + WS_RTS); S.cnt = (const int*)(F.ctl + CW_CNT); S.G = F.G; S.c = F.vcu;
        pg8::EpiDown E; E.row_ts = (const int*)(ws + WS_RTS); E.row_w = (const float*)(ws + WS_RW); E.contrib = (unsigned char*)P.out;
        pg8::gemm_phase<pg8::EpiDown, MoeOrder<8, false>, true, true, true>(F.lds + RING_OFF, F.wave, 512, 512, 512, S, E);
        if (BOTH(8)) GRID_BAR();
    }
    if (IN(9)) { p9_combine(F, P); if (BOTH(9)) GRID_BAR(); }
    if (IN(10)) {
        pg8::DenseOrder S; S.init(ws + WS_X2F8, ws + WS_WPG, 1024, 1024, M, 2048, F.G, (int)blockIdx.x);
        pg8::EpiGate E; E.x2b = (const bf16*)(ws + WS_B); E.pp = (const unsigned char*)(ws + WS_PP); E.r2 = (const float*)(ws + WS_R2); E.x3b = (bf16*)(ws + WS_B2); E.ssq = (float*)(ws + WS_SSQ3);
        pg8::gemm_phase<pg8::EpiGate, pg8::DenseOrder, true, true, true>(F.lds + RING_OFF, F.wave, 2048, 2048, 2048, S, E);
        if (BOTH(10)) GRID_BAR();
    }
    if (IN(11)) { p11_final(F, P); }
#undef IN
#undef BOTH
}

extern "C" void kernel_launch(void* const* d_in, const int* in_sizes, int n_in, void* d_out, int out_size, void* d_ws, size_t ws_size, hipStream_t stream) {
    static int grid = 0;
    if (grid == 0) {
        if (n_in != 34 || out_size != M * D || ws_size < WS_END) { fprintf(stderr, "kernel_launch: unexpected shapes (n_in %d, out %d, ws %zu); nothing launched\n", n_in, out_size, ws_size); grid = -1; return; }
        int dev = 0, cus = 0, per_cu = 0;
        if (hipGetDevice(&dev) != hipSuccess || hipDeviceGetAttribute(&cus, hipDeviceAttributeMultiprocessorCount, dev) != hipSuccess) { grid = -1; return; }
        if (hipFuncSetAttribute((const void*)mk_fwd, hipFuncAttributeMaxDynamicSharedMemorySize, LDS_BYTES) != hipSuccess) { fprintf(stderr, "kernel_launch: hipFuncSetAttribute failed\n"); grid = -1; return; }
        if (hipOccupancyMaxActiveBlocksPerMultiprocessor(&per_cu, (const void*)mk_fwd, NWAVES * 64, LDS_BYTES) != hipSuccess || per_cu < 1) { fprintf(stderr, "kernel_launch: occupancy query reports %d\n", per_cu); per_cu = 1; }
        (void)hipGetLastError();
        grid = cus;
    }
    if (grid < 0) return;
    if (hipMemsetAsync((char*)d_ws + WS_CTL, 0, CTL_ZERO_BYTES, stream) != hipSuccess) return;
    Args a{};
    for (int i = 0; i < 34; ++i) a.in[i] = (const float*)d_in[i];
    a.out = (float*)d_out; a.ws = (unsigned char*)d_ws; a.pad = 0;
    if (MK_ONE_LAUNCH) { a.ph_lo = 0; a.ph_hi = NPH; a.li = 0; hipLaunchKernelGGL(mk_fwd, dim3(grid), dim3(NWAVES * 64), LDS_BYTES, stream, a); }
    else for (int li = 0; li < NPH; ++li) { a.ph_lo = li; a.ph_hi = li + 1; a.li = li; hipLaunchKernelGGL(mk_fwd, dim3(grid), dim3(NWAVES * 64), LDS_BYTES, stream, a); }
}
```
